# Optimizing an MI355X kernel written in HIP

```python
import math
import jax, jax.numpy as jnp
from jax import lax
import numpy as np

D_MODEL = 1024
BATCH = 4
SEQ = 8192
DEPTH = 1

GRID_W = 64
CTX_LEN = 256
EPS = 1e-6
GLA_HEADS = 4
GLA_DK = D_MODEL // (2 * GLA_HEADS)
GLA_DV = D_MODEL // GLA_HEADS
GLA_WIDTH = GLA_HEADS * GLA_DV
GLA_RANK = 16
GLA_TAU = 16.0
GLA_CHUNK = 64
DIFF_DK = 64
DIFF_DV = 2 * DIFF_DK
DIFF_HEADS = D_MODEL // DIFF_DV
DIFF_WIDTH = DIFF_HEADS * DIFF_DV
Q_BLOCK = 128
ROPE_BASE = 10000.0
ROPE_AXIS_DIM = DIFF_DK // 2
IN_SIZES = (GLA_HEADS * GLA_DK, GLA_HEADS * GLA_DK, GLA_WIDTH, GLA_WIDTH, 2 * GLA_RANK,
            DIFF_HEADS * 2 * DIFF_DK, DIFF_HEADS * 2 * DIFF_DK, DIFF_WIDTH, DIFF_WIDTH,
            D_MODEL, D_MODEL)
IN_WIDTH = sum(IN_SIZES)

kernel_name = 'hybrid_gla_diffattn_gated_parallel_block'


def rms_norm(t):
    tf = t.astype(jnp.float32)
    return (tf * lax.rsqrt(jnp.mean(tf * tf, axis=-1, keepdims=True) + EPS)).astype(t.dtype)


def modulate(t, shift, scale):
    return rms_norm(t) * (1 + scale) + shift


def heads(t, n):
    b_, l_, w_ = t.shape
    return t.reshape(b_, l_, n, w_ // n).transpose(0, 2, 1, 3)


def merge_heads(t):
    b_, h_, l_, d_ = t.shape
    return t.transpose(0, 2, 1, 3).reshape(b_, l_, h_ * d_)


def rev(t):
    return jnp.flip(t, axis=2)


def project(h, w_in):
    p = h @ w_in
    return jnp.split(p, np.cumsum(IN_SIZES)[:-1].tolist(), axis=-1)


def axial_rope_tables(n_tokens, dtype):
    rows = n_tokens // GRID_W
    row = jnp.repeat(jnp.arange(rows, dtype=jnp.float32), GRID_W)
    col = jnp.tile(jnp.arange(GRID_W, dtype=jnp.float32), rows)
    inv_freq = ROPE_BASE ** (-jnp.arange(0, ROPE_AXIS_DIM, 2, dtype=jnp.float32) / ROPE_AXIS_DIM)
    ang_r = row[:, None] * inv_freq
    ang_c = col[:, None] * inv_freq
    two = lambda a: jnp.concatenate([a, a], axis=-1).astype(dtype)
    return (two(jnp.cos(ang_r)), two(jnp.sin(ang_r)), two(jnp.cos(ang_c)), two(jnp.sin(ang_c)))


def rope_axis(t, cos, sin):
    t1, t2 = jnp.split(t, 2, axis=-1)
    return t * cos + jnp.concatenate([-t2, t1], axis=-1) * sin


def apply_rope(t, tabs):
    cr, sr, cc, sc = tabs
    tr, tc = jnp.split(t, 2, axis=-1)
    return jnp.concatenate([rope_axis(tr, cr, sr), rope_axis(tc, cc, sc)], axis=-1)


def gla_streams(gq, gk, gv, g_lr, w_dec, b_dec):
    q = heads(gq, GLA_HEADS) * GLA_DK ** -0.5
    k = heads(gk, GLA_HEADS)
    v = heads(gv, GLA_HEADS)
    lr_f, lr_b = jnp.split(g_lr, 2, axis=-1)
    la_f = jax.nn.log_sigmoid((lr_f @ w_dec[0] + b_dec[0]).astype(jnp.float32)) / GLA_TAU
    la_b = jax.nn.log_sigmoid((lr_b @ w_dec[1] + b_dec[1]).astype(jnp.float32)) / GLA_TAU
    return q, k, v, heads(la_f, GLA_HEADS), heads(la_b, GLA_HEADS)


def gla_final_state(k, v, log_a):
    cum = jnp.cumsum(log_a.astype(jnp.float32), axis=2)
    k_dec = k.astype(jnp.float32) * jnp.exp(cum[:, :, -1:] - cum)
    return jnp.einsum('bhld,bhlv->bhdv', k_dec, v.astype(jnp.float32))


def gla_chunked(q, k, v, log_a, s0):
    b_, h_, l_, _ = q.shape
    dv = v.shape[-1]
    n = l_ // GLA_CHUNK

    def chunks(t):
        return t.astype(jnp.float32).reshape(b_, h_, n, GLA_CHUNK, t.shape[-1])

    q, k, v, log_a = chunks(q), chunks(k), chunks(v), chunks(log_a)
    cum = jnp.cumsum(log_a, axis=3)
    ref = cum[:, :, :, GLA_CHUNK // 2 - 1:GLA_CHUNK // 2]
    scores = jnp.einsum('bhnid,bhnjd->bhnij', q * jnp.exp(cum - ref), k * jnp.exp(ref - cum))
    tri = jnp.tril(jnp.ones((GLA_CHUNK, GLA_CHUNK), dtype=bool))
    o_intra = jnp.einsum('bhnij,bhnjv->bhniv', jnp.where(tri, scores, 0.0), v)
    last = cum[:, :, :, -1:]
    q_inter = q * jnp.exp(cum)
    k_state = k * jnp.exp(last - cum)
    decay = jnp.exp(last[:, :, :, 0])

    def step(s, inp):
        qc, kc, vc, dc = inp
        o = jnp.einsum('bhid,bhdv->bhiv', qc, s)
        s = dc[..., None] * s + jnp.einsum('bhid,bhiv->bhdv', kc, vc)
        return s, o

    front = lambda t: jnp.moveaxis(t, 2, 0)
    _, o_inter = lax.scan(step, s0.astype(jnp.float32),
                          (front(q_inter), front(k_state), front(v), front(decay)))
    o = o_intra + jnp.moveaxis(o_inter, 0, 2)
    return o.reshape(b_, h_, l_, dv)


def bidir_gla(q, k, v, la_f, la_b, s_f, s_b):
    fwd = gla_chunked(q, k, v, la_f, s_f)
    bwd = rev(gla_chunked(rev(q), rev(k), rev(v), rev(la_b), s_b))
    return (fwd + bwd).astype(v.dtype)


def diff_streams(dq, dk, dv, q_gain, k_gain):
    q1, q2 = jnp.split(heads(dq, DIFF_HEADS), 2, axis=-1)
    k1, k2 = jnp.split(heads(dk, DIFF_HEADS), 2, axis=-1)
    v = heads(dv, DIFF_HEADS)
    return (rms_norm(q1) * q_gain, rms_norm(q2) * q_gain,
            rms_norm(k1) * k_gain, rms_norm(k2) * k_gain, v)


def diff_lambda_value(lam_params, lam_init):
    lq1, lk1, lq2, lk2 = lam_params.astype(jnp.float32)
    return jnp.exp(jnp.sum(lq1 * lk1)) - jnp.exp(jnp.sum(lq2 * lk2)) + lam_init


def diff_attention(q1, q2, k1, k2, v, lam):
    b_, h_, lq, d = q1.shape
    nb = lq // Q_BLOCK
    scale = d ** -0.5

    def blocks(t):
        return jnp.moveaxis(t.reshape(b_, h_, nb, Q_BLOCK, d), 2, 0)

    def one_block(qs):
        qb1, qb2 = qs
        s1 = jnp.einsum('bhqd,bhkd->bhqk', qb1, k1).astype(jnp.float32) * scale
        s2 = jnp.einsum('bhqd,bhkd->bhqk', qb2, k2).astype(jnp.float32) * scale
        a = jax.nn.softmax(s1, axis=-1) - lam * jax.nn.softmax(s2, axis=-1)
        return jnp.einsum('bhqk,bhkv->bhqv', a.astype(v.dtype), v)

    o = lax.map(one_block, (blocks(q1), blocks(q2)))
    return jnp.moveaxis(o, 0, 2).reshape(b_, h_, lq, v.shape[-1])


def combine(o_gla, gla_gate, o_diff, diff_gate, m_gla, m_diff,
            gla_gain, diff_gain, lam_init, w_br_gla, w_br_diff, w_out):
    a = merge_heads(rms_norm(o_gla) * gla_gain) * jax.nn.silu(gla_gate)
    b = merge_heads(rms_norm(o_diff) * diff_gain * (1 - lam_init)) * jax.nn.silu(diff_gate)
    y = jax.nn.sigmoid(m_gla) * (a @ w_br_gla) + jax.nn.sigmoid(m_diff) * (b @ w_br_diff)
    return y @ w_out


def setup_inputs(seed: int = 0) -> dict:
    key = jax.random.key(seed)
    ks = jax.random.split(key, 17)
    nrm = lambda k, shape, s: jax.random.normal(k, shape, jnp.float32) * s
    return {
        'x': nrm(ks[0], (BATCH, SEQ, D_MODEL), 1.0),
        'c': nrm(ks[1], (BATCH, D_MODEL), 1.0),
        'ctx': nrm(ks[2], (BATCH, CTX_LEN, D_MODEL), 1.0),
        'c_ctx': nrm(ks[3], (D_MODEL,), 1.0),
        'w_ada': nrm(ks[4], (DEPTH, D_MODEL, 3 * D_MODEL), D_MODEL ** -0.5),
        'b_ada': nrm(ks[5], (DEPTH, 3 * D_MODEL), 0.02),
        'w_in': nrm(ks[6], (DEPTH, D_MODEL, IN_WIDTH), D_MODEL ** -0.5),
        'gla_w_decay': nrm(ks[7], (DEPTH, 2, GLA_RANK, GLA_HEADS * GLA_DK), GLA_RANK ** -0.5),
        'gla_b_decay': nrm(ks[8], (DEPTH, 2, GLA_HEADS * GLA_DK), 0.1),
        'gla_norm': 1.0 + nrm(ks[9], (DEPTH, GLA_DV), 0.02),
        'diff_q_norm': 1.0 + nrm(ks[10], (DEPTH, DIFF_DK), 0.02),
        'diff_k_norm': 1.0 + nrm(ks[11], (DEPTH, DIFF_DK), 0.02),
        'diff_lambda': nrm(ks[12], (DEPTH, 4, DIFF_DK), 0.1),
        'diff_norm': 1.0 + nrm(ks[13], (DEPTH, DIFF_DV), 0.02),
        'w_br_gla': nrm(ks[14], (DEPTH, GLA_WIDTH, D_MODEL), GLA_WIDTH ** -0.5),
        'w_br_diff': nrm(ks[15], (DEPTH, DIFF_WIDTH, D_MODEL), DIFF_WIDTH ** -0.5),
        'w_out': nrm(ks[16], (DEPTH, D_MODEL, D_MODEL), D_MODEL ** -0.5),
    }


def reference(x, c, ctx, c_ctx, w_ada, b_ada, w_in, gla_w_decay, gla_b_decay, gla_norm,
              diff_q_norm, diff_k_norm, diff_lambda, diff_norm, w_br_gla, w_br_diff, w_out):
    rope = axial_rope_tables(x.shape[1], x.dtype)
    for layer in range(DEPTH):
        lam_init = 0.8 - 0.6 * math.exp(-0.3 * layer)
        mod_x = jax.nn.silu(c) @ w_ada[layer] + b_ada[layer]
        mod_c = jax.nn.silu(c_ctx) @ w_ada[layer] + b_ada[layer]
        sh_x, sc_x, g_x = jnp.split(mod_x[:, None, :], 3, axis=-1)
        sh_c, sc_c, g_c = jnp.split(mod_c, 3, axis=-1)
        pl = project(modulate(x, sh_x, sc_x), w_in[layer])
        pc = project(modulate(ctx, sh_c, sc_c), w_in[layer])

        q, k, v, la_f, la_b = gla_streams(pl[0], pl[1], pl[2], pl[4],
                                          gla_w_decay[layer], gla_b_decay[layer])
        qc, kc, vc, la_fc, la_bc = gla_streams(pc[0], pc[1], pc[2], pc[4],
                                               gla_w_decay[layer], gla_b_decay[layer])
        s_f = gla_final_state(kc, vc, la_fc)
        s_b = gla_final_state(rev(kc), rev(vc), rev(la_bc))
        o_gla = bidir_gla(q, k, v, la_f, la_b, s_f, s_b)

        q1, q2, k1, k2, dv = diff_streams(pl[5], pl[6], pl[7], diff_q_norm[layer], diff_k_norm[layer])
        q1, q2, k1, k2 = (apply_rope(q1, rope), apply_rope(q2, rope),
                          apply_rope(k1, rope), apply_rope(k2, rope))
        cq1, cq2, ck1, ck2, cv = diff_streams(pc[5], pc[6], pc[7], diff_q_norm[layer], diff_k_norm[layer])
        lam = diff_lambda_value(diff_lambda[layer], lam_init)
        o_diff = diff_attention(q1, q2,
                                jnp.concatenate([ck1, k1], axis=2),
                                jnp.concatenate([ck2, k2], axis=2),
                                jnp.concatenate([cv, dv], axis=2), lam)

        out_x = combine(o_gla, pl[3], o_diff, pl[8], pl[9], pl[10], gla_norm[layer], diff_norm[layer],
                        lam_init, w_br_gla[layer], w_br_diff[layer], w_out[layer])
        if layer < DEPTH - 1:
            zero = jnp.zeros_like(s_f)
            o_gla_c = bidir_gla(qc, kc, vc, la_fc, la_bc, zero, zero)
            o_diff_c = diff_attention(cq1, cq2, ck1, ck2, cv, lam)
            out_c = combine(o_gla_c, pc[3], o_diff_c, pc[8], pc[9], pc[10], gla_norm[layer],
                            diff_norm[layer], lam_init, w_br_gla[layer], w_br_diff[layer], w_out[layer])
            ctx = ctx + g_c * out_c
        x = x + g_x * out_x
    return x
```

```cpp
#include <hip/hip_runtime.h>
#include <hip/hip_cooperative_groups.h>
#include <cstdio>
#include <cstdint>
namespace cg = cooperative_groups;

typedef unsigned short bf16_t;
typedef float f32x4 __attribute__((ext_vector_type(4)));
typedef unsigned u32x4 __attribute__((ext_vector_type(4)));
typedef unsigned u32x2 __attribute__((ext_vector_type(2)));

constexpr int DM = 1024, NB = 4, SEQ = 8192, CTXL = 256;
constexpr int NLAT = NB * SEQ, NCTX = NB * CTXL, NROW = NLAT + NCTX;
constexpr int INW = 9248;
constexpr float EPS = 1e-6f;
constexpr float LOG2E = 1.4426950408889634f;
constexpr float QC2 = 0.125f * LOG2E;
constexpr float LAM_INIT = 0.2f;
constexpr int C_GQ = 0, C_GK = 512, C_GV = 1024, C_GG = 2048, C_LR = 3072, C_DQ = 3104, C_DK = 4128, C_DV = 5152, C_DG = 6176, C_MG = 7200, C_MD = 8224;

constexpr size_t MiB = 1u << 20;
constexpr size_t WS_MOD = 0;
constexpr size_t WS_CTR = 61440;
constexpr size_t WS_BAR = 65536;
constexpr size_t WS_ZERO_BYTES = 81920;
constexpr size_t WS_TAB = 81920;
constexpr size_t WS_RSTDG = 128 * 1024;
constexpr size_t WS_WINT = 1 * MiB, WS_WBRT = 21 * MiB, WS_WOUTT = 25 * MiB;
constexpr size_t WS_H = 28 * MiB;
constexpr size_t WS_GQ = 94 * MiB;
constexpr size_t WS_GK = 127 * MiB;
constexpr size_t WS_A = WS_GQ;
constexpr size_t WS_GV = 160 * MiB;
constexpr size_t WS_SG = WS_GV;
constexpr size_t WS_DK = 226 * MiB;
constexpr size_t WS_SD = WS_DK;
constexpr size_t WS_DV = 292 * MiB;
constexpr size_t WS_Y = WS_DV;
constexpr size_t WS_DQ = 358 * MiB;
constexpr size_t WS_LR = 422 * MiB;
constexpr size_t WS_LAT = 427 * MiB;
constexpr size_t WS_END = 493 * MiB;

#define PROBE 0
constexpr int NTHREADS = 512;
constexpr int LDS_BYTES = 163840;

struct Params {
    const float *x, *c, *ctx, *c_ctx, *w_ada, *b_ada, *w_in, *w_dec, *b_dec, *gla_norm, *qn, *kn, *dlam, *dnorm, *w_brg, *w_brd, *w_out;
    float* out; unsigned char* ws;
    int ph_lo, ph_hi;
};

__device__ __forceinline__ float bf2f(bf16_t v) { return __uint_as_float(((unsigned)v) << 16); }
__device__ __forceinline__ unsigned f2bf(float f) { unsigned u = __float_as_uint(f); return (u + 0x7fffu + ((u >> 16) & 1u)) >> 16; }
__device__ __forceinline__ unsigned pk2(float lo, float hi) { return f2bf(lo) | (f2bf(hi) << 16); }
__device__ __forceinline__ float siluf(float v) { return v / (1.f + expf(-v)); }
__device__ __forceinline__ float sigmf(float v) { return 1.f / (1.f + expf(-v)); }
__device__ __forceinline__ float logsigf(float z) { return fminf(z, 0.f) - log1pf(expf(-fabsf(z))); }
__device__ __forceinline__ float wave_sum(float v) {
#pragma unroll
    for (int o = 1; o < 64; o <<= 1) v += __shfl_xor(v, o);
    return v;
}
__device__ __forceinline__ float lam_value(const float* dl) {
    float s1 = 0.f, s2 = 0.f;
    for (int i = 0; i < 64; ++i) { s1 += dl[i] * dl[64 + i]; s2 += dl[128 + i] * dl[192 + i]; }
    return expf(s1) - expf(s2) + LAM_INIT;
}
__device__ __forceinline__ float attn_shift(const float* qn, const float* kn) {
    float mq = 0.f, mk = 0.f;
    for (int i = 0; i < 64; ++i) { mq = fmaxf(mq, fabsf(qn[i])); mk = fmaxf(mk, fabsf(kn[i])); }
    return 8.f * LOG2E * mq * mk * 1.01f + 0.1f;
}


__device__ __forceinline__ int lane_id() { return (int)__builtin_amdgcn_mbcnt_hi(~0u, __builtin_amdgcn_mbcnt_lo(~0u, 0u)); }
#define GET_TID(ws_) ((ws_) * 64 + lane_id())

#define LAS __attribute__((address_space(3)))
#define XB_TMO      128
#define XB_XCNT(j)  (256  + 64 * (j))
#define XB_XSUB(j)  (1280 + 64 * (j))
#define XB_XGEN(j)  (2304 + 64 * (j))
#define XB_TOP      3328
#define XB_TOPGEN   3392
#define XCD_BAR_WORDS 3456
#define XB_SPIN_CAP (1u << 18)

__device__ __forceinline__ unsigned xb_ld(unsigned* p)              { return __hip_atomic_load(p, __ATOMIC_RELAXED, __HIP_MEMORY_SCOPE_AGENT); }
__device__ __forceinline__ unsigned xb_add(unsigned* p, unsigned v) { return __hip_atomic_fetch_add(p, v, __ATOMIC_RELAXED, __HIP_MEMORY_SCOPE_AGENT); }
__device__ __forceinline__ unsigned xb_xcc_id() { return (unsigned)__builtin_amdgcn_s_getreg((3 << 11) | 20) & 0xFu; }
#define XB_SPIN(cond, bar) do { unsigned _sp = 0; while (cond) { __builtin_amdgcn_s_sleep(1); \
    if ((++_sp & 255u) == 0u) { if (xb_ld(&(bar)[XB_TMO])) break; if (_sp > XB_SPIN_CAP) { atomicAdd(&(bar)[XB_TMO], 1u); break; } } } } while (0)

struct XcdBarrier {
    unsigned* bar; unsigned x;
    volatile LAS unsigned* st;
};

__device__ __forceinline__ XcdBarrier xcd_barrier_post(unsigned* bar, volatile LAS unsigned* st, bool tid0, unsigned& rank) {
    XcdBarrier b; b.bar = bar; b.x = xb_xcc_id(); b.st = st;
    rank = 0u; if (tid0) rank = xb_add(&bar[XB_XCNT(b.x)], 1u);
    return b;
}
__device__ __forceinline__ void xcd_barrier_complete(unsigned* bar, unsigned x, unsigned& nloc, unsigned& nx) {
    const unsigned G = gridDim.x * gridDim.y * gridDim.z;
    unsigned sum, cnt, mine, sp = 0u;
    for (;;) {
        sum = 0u; cnt = 0u; mine = 0u;
#pragma unroll
        for (unsigned j = 0; j < 16; ++j) { const unsigned c = xb_ld(&bar[XB_XCNT(j)]); sum += c; cnt += (c > 0u) ? 1u : 0u; mine = (j == x) ? c : mine; }
        if (sum == G) break;
        __builtin_amdgcn_s_sleep(1);
        if ((++sp & 255u) == 0u) { if (xb_ld(&bar[XB_TMO])) break; if (sp > XB_SPIN_CAP) { atomicAdd(&bar[XB_TMO], 1u); break; } }
    }
    nloc = mine > 0u ? mine : 1u; nx = cnt > 0u ? cnt : 1u;
}

__device__ __forceinline__ void xcd_barrier(const XcdBarrier& b, bool tid0, bool wait = true) {
    asm volatile("s_waitcnt vmcnt(0)" ::: "memory");
    __syncthreads();
    if (tid0) {
        unsigned* bar = b.bar;
        __builtin_amdgcn_s_waitcnt(0);
        unsigned nloc = b.st[0], nx = b.st[1];
        if (nloc == 0u) { xcd_barrier_complete(bar, b.x, nloc, nx); b.st[0] = nloc; b.st[1] = nx; }
        const unsigned old = xb_add(&bar[XB_XSUB(b.x)], 1u);
        const unsigned gen = old / nloc;
        if (old + 1u == (gen + 1u) * nloc) {
            __builtin_amdgcn_fence(__ATOMIC_RELEASE, "agent");
            asm volatile("s_waitcnt vmcnt(0)" ::: "memory");
            const unsigned og = xb_add(&bar[XB_TOP], 1u);
            const unsigned tg = og / nx;
            if (og + 1u == (tg + 1u) * nx) xb_add(&bar[XB_TOPGEN], 1u);
            else XB_SPIN(xb_ld(&bar[XB_TOPGEN]) <= tg, bar);
            __builtin_amdgcn_fence(__ATOMIC_ACQUIRE, "agent");
            xb_add(&bar[XB_XGEN(b.x)], 1u);
            asm volatile("s_waitcnt vmcnt(0)" ::: "memory");
        } else if (wait) {
            XB_SPIN(xb_ld(&bar[XB_XGEN(b.x)]) <= gen, bar);
            __builtin_amdgcn_fence(__ATOMIC_ACQUIRE, "agent");
            asm volatile("s_waitcnt vmcnt(0)" ::: "memory");
        }
    }
    __syncthreads();
}


__device__ __forceinline__ void p0a_naive(const Params& p, int wv, unsigned char* smem) {
    int tid = GET_TID(wv); asm volatile("" : "+v"(tid)); const int lane = tid & 63, wave = tid >> 6;
    const int gw = blockIdx.x * 8 + wave, NGW = gridDim.x * 8;
    float* MOD = (float*)(p.ws + WS_MOD);
    float* SC = (float*)(smem + 131072);
    for (int e = tid; e < 5 * 1024; e += NTHREADS) SC[e] = siluf(e < 4096 ? p.c[e] : p.c_ctx[e - 4096]);
    __syncthreads();
    for (int it = gw; it < 3072; it += NGW) {
        const int cc = it % 48, ks = it / 48, n = cc * 64 + lane;
        float a0 = 0.f, a1 = 0.f, a2 = 0.f, a3 = 0.f, a4 = 0.f;
        float wv_[16];
#pragma unroll
        for (int j = 0; j < 16; ++j) wv_[j] = p.w_ada[(size_t)(ks * 16 + j) * 3072 + n];
#pragma unroll
        for (int j = 0; j < 16; ++j) { const int k = ks * 16 + j; const float w = wv_[j];
            a0 += SC[k] * w; a1 += SC[1024 + k] * w; a2 += SC[2048 + k] * w; a3 += SC[3072 + k] * w; a4 += SC[4096 + k] * w;
        }
        if (ks == 0) { const float bb = p.b_ada[n]; a0 += bb; a1 += bb; a2 += bb; a3 += bb; a4 += bb; }
        atomicAdd(&MOD[n], a0); atomicAdd(&MOD[3072 + n], a1); atomicAdd(&MOD[2 * 3072 + n], a2); atomicAdd(&MOD[3 * 3072 + n], a3); atomicAdd(&MOD[4 * 3072 + n], a4);
    }
    float* TAB = (float*)(p.ws + WS_TAB);
    const int gt = blockIdx.x * NTHREADS + tid;
    if (gt < 2048) {
        const int pos = gt >> 4, i = gt & 15;
        const float inv = powf(10000.f, -(float)(2 * i) / 32.f);
        const float ang = (float)pos * inv;
        TAB[gt] = cosf(ang); TAB[2048 + gt] = sinf(ang);
    }
}
__device__ __forceinline__ void p0b_norm(const Params& p, int wv) {
    int tid = GET_TID(wv); asm volatile("" : "+v"(tid)); const int lane = tid & 63, wave = tid >> 6;
    const int gw = blockIdx.x * 8 + wave, NGW = gridDim.x * 8;
    const float* MOD = (const float*)(p.ws + WS_MOD);
    bf16_t* H = (bf16_t*)(p.ws + WS_H);
#define P0B_SRC(r_) ((r_) < NLAT ? p.x + (size_t)(r_) * DM : p.ctx + (size_t)((r_) - NLAT) * DM)
    f32x4 vn[2][2];
    if (gw < NROW) { const float* xr = P0B_SRC(gw);
#pragma unroll
        for (int j = 0; j < 2; ++j)
#pragma unroll
            for (int q = 0; q < 2; ++q) vn[j][q] = *(const f32x4*)(xr + 512 * j + 8 * lane + 4 * q); }
    for (int row = gw; row < NROW; row += NGW) {
        const int mr = row < NLAT ? row >> 13 : 4;
        f32x4 v[2][2]; float ss = 0.f;
#pragma unroll
        for (int j = 0; j < 2; ++j)
#pragma unroll
            for (int q = 0; q < 2; ++q) v[j][q] = vn[j][q];
        if (row + NGW < NROW) { const float* xr = P0B_SRC(row + NGW);
#pragma unroll
            for (int j = 0; j < 2; ++j)
#pragma unroll
                for (int q = 0; q < 2; ++q) vn[j][q] = *(const f32x4*)(xr + 512 * j + 8 * lane + 4 * q); }
#pragma unroll
        for (int j = 0; j < 2; ++j)
#pragma unroll
            for (int q = 0; q < 2; ++q) ss += v[j][q].x * v[j][q].x + v[j][q].y * v[j][q].y + v[j][q].z * v[j][q].z + v[j][q].w * v[j][q].w;
        ss = wave_sum(ss);
        const float rstd = rsqrtf(ss * (1.f / DM) + EPS);
#pragma unroll
        for (int j = 0; j < 2; ++j) {
            const int k = 512 * j + 8 * lane;
            u32x4 o;
            { const f32x4 sh = *(const f32x4*)(MOD + mr * 3072 + k), sc = *(const f32x4*)(MOD + mr * 3072 + 1024 + k); const f32x4 h = v[j][0] * rstd * (sc + 1.f) + sh; o.x = pk2(h.x, h.y); o.y = pk2(h.z, h.w); }
            { const f32x4 sh = *(const f32x4*)(MOD + mr * 3072 + k + 4), sc = *(const f32x4*)(MOD + mr * 3072 + 1024 + k + 4); const f32x4 h = v[j][1] * rstd * (sc + 1.f) + sh; o.z = pk2(h.x, h.y); o.w = pk2(h.z, h.w); }
            *(u32x4*)(H + (size_t)row * DM + k) = o;
        }
    }
}

namespace fa {
using bf16x8 = __attribute__((ext_vector_type(8))) short;
using s16x4  = __attribute__((ext_vector_type(4))) short;
using f32x16 = __attribute__((ext_vector_type(16))) float;
constexpr int KVBLK = 64;
#define FA_SBAR() __builtin_amdgcn_sched_barrier(0)
__device__ __forceinline__ int crow(int r, int hi) { return (r & 3) + 8 * (r >> 2) + 4 * hi; }
typedef float f32x2_t __attribute__((ext_vector_type(2))); typedef __bf16 bf16x2_t __attribute__((ext_vector_type(2)));
__device__ __forceinline__ unsigned cvtpk(float lo, float hi) { f32x2_t v = {lo, hi}; bf16x2_t bb = __builtin_convertvector(v, bf16x2_t); return __builtin_bit_cast(unsigned, bb); }
__device__ __forceinline__ int v_st(int k, int c) { const int kk = (k & ~0xC) | ((k & 4) << 1) | ((k & 8) >> 1); return ((kk >> 3) * 4 + (c >> 5)) * 512 + ((kk & 7) * 32 + (c & 31)) * 2; }
__device__ __forceinline__ int v_rd_base(int lane) { return ((lane & 3) << 3) | (((lane >> 2) & 3) << 6) | (((lane >> 4) & 1) << 5) | (((lane >> 5) & 1) << 8); }
__device__ __forceinline__ int kvrow(int b, int j) { return j < 4 ? NLAT + b * CTXL + 64 * j : b * SEQ + 64 * (j - 4); }

typedef short v4i16_t __attribute__((ext_vector_type(4)));
#define FA_LAS __attribute__((address_space(3)))
__device__ __forceinline__ s16x4 vtr(const FA_LAS char* p) { return __builtin_bit_cast(s16x4, __builtin_amdgcn_ds_read_tr16_b64_v4i16((FA_LAS v4i16_t*)p)); }
#define FA_PKF(Lo, Hi) (bf16x8){Lo[0], Lo[1], Lo[2], Lo[3], Hi[0], Hi[1], Hi[2], Hi[3]}

constexpr int KRING = 0, VRING = 3 * 16384, WSF_OFF = 6 * 16384;
template <bool SHIFT>
__device__ __forceinline__ void attn_unit2(int b, int h, int qb, bf16_t* QB, bf16_t* OBN, const bf16_t* __restrict__ Kg, const bf16_t* __restrict__ Vg,
                                           const float* __restrict__ dnorm, float lam, float negm, char* lds, int wv) {
    int tid = GET_TID(wv); asm volatile("" : "+v"(tid));
    const int wid = wv, lane = tid & 63, r32 = lane & 31, hi = lane >> 5, wq = wid & 3, sidx = wid >> 2;
    FA_LAS char* L = (FA_LAS char*)lds;
    float* wsf = (float*)(lds + WSF_OFF) + wid * 64;
    float l_reg = 0.f; f32x16 o[4] = {}; bf16x8 qr[4];
    const int qrow0 = b * SEQ + qb * 128 + wq * 32;
    char* QBc = (char*)QB;
    {
        const unsigned qo = ((unsigned)(qrow0 + r32) * DM + 128 * h + 64 * sidx + hi * 8) * 2u;
#pragma unroll
        for (int d0 = 0; d0 < 4; ++d0) qr[d0] = *reinterpret_cast<const bf16x8*>(QBc + qo + d0 * 32);
    }
    const char* Kc = (const char*)Kg; const char* Vc = (const char*)Vg;
    const unsigned ksrc = (unsigned)lane * 2048u + 256u * h + (unsigned)(2 * wid) * 16u;
    const unsigned vsrc = (unsigned)(16 * ((2 * wid) & 3) + (lane >> 2)) * 2048u + 256u * h + (unsigned)(32 * ((2 * wid) >> 2) + (lane & 3) * 8) * 2u;
    const int dmaoff = (2 * wid) * 1024;
#define A2_DMA_K(t, slotoff) do { const char* kp_ = Kc + (unsigned)kvrow(b, (t)) * 2048u + ksrc; FA_LAS char* sl_ = L + KRING + (slotoff) + dmaoff; \
        __builtin_amdgcn_global_load_lds((const unsigned*)(kp_), (FA_LAS unsigned*)(sl_), 16, 0, 0); \
        __builtin_amdgcn_global_load_lds((const unsigned*)(kp_ + 16), (FA_LAS unsigned*)(sl_ + 1024), 16, 0, 0); } while (0)
#define A2_DMA_V(t, slotoff) do { const char* vp_ = Vc + (unsigned)kvrow(b, (t)) * 2048u + vsrc; FA_LAS char* sl_ = L + VRING + (slotoff) + dmaoff; \
        __builtin_amdgcn_global_load_lds((const unsigned*)(vp_), (FA_LAS unsigned*)(sl_), 16, 0, 0); \
        __builtin_amdgcn_global_load_lds((const unsigned*)(vp_ + 16 * 2048), (FA_LAS unsigned*)(sl_ + 1024), 16, 0, 0); } while (0)
#define A2_DMA_K1(t, slotoff, i) do { const char* kp_ = Kc + (unsigned)kvrow(b, (t)) * 2048u + ksrc + (i) * 16; FA_LAS char* sl_ = L + KRING + (slotoff) + dmaoff + (i) * 1024; \
        __builtin_amdgcn_global_load_lds((const unsigned*)(kp_), (FA_LAS unsigned*)(sl_), 16, 0, 0); } while (0)
#define A2_DMA_V1(t, slotoff, i) do { const char* vp_ = Vc + (unsigned)kvrow(b, (t)) * 2048u + vsrc + (i) * (16 * 2048); FA_LAS char* sl_ = L + VRING + (slotoff) + dmaoff + (i) * 1024; \
        __builtin_amdgcn_global_load_lds((const unsigned*)(vp_), (FA_LAS unsigned*)(sl_), 16, 0, 0); } while (0)
#define A2_WBAR(N) asm volatile("s_waitcnt vmcnt(" #N ") lgkmcnt(0)\n\ts_barrier" ::: "memory")
    const FA_LAS char* kp0 = L + KRING + (8 * sidx + hi) * 1024 + r32 * 16;
    const FA_LAS char* vp0 = L + VRING + ((lane >> 4) & 1) * 32 + (lane & 3) * 8 + (4 * hi + ((lane & 15) >> 2)) * 64;
    constexpr int NT = (CTXL + SEQ) / KVBLK;
    bf16x8 kf[8]; s16x4 vlo[8], vhi[8]; u32x4 pw0, pw1, pw2, pw3; f32x16 pA0, pA1, pB0, pB1;
    const f32x16 ZERO = {};
    int sl_prev = 0, sl_cur = 0, sl_next = 16384;
#define A2_ROT() do { sl_prev = sl_cur; sl_cur = sl_next; sl_next = (sl_next == 32768) ? 0 : sl_next + 16384; } while (0)
#define A2_KLOAD2(kp, j) do { kf[2 * (j)] = *(const FA_LAS bf16x8*)((kp) + (j) * 2048); kf[2 * (j) + 1] = *(const FA_LAS bf16x8*)((kp) + (j) * 2048 + 512); } while (0)
#define A2_VRD(i, fi) do { vlo[i] = vtr(vp_ + ((fi) & 3) * 4096 + ((fi) >> 2) * 1024); vhi[i] = vtr(vp_ + ((fi) & 3) * 4096 + ((fi) >> 2) * 1024 + 512); } while (0)
#define A2_VFR(i) (bf16x8){vlo[i][0], vlo[i][1], vlo[i][2], vlo[i][3], vhi[i][0], vhi[i][1], vhi[i][2], vhi[i][3]}
#define A2_PIN(x) asm volatile("" : "+v"(x))
#define A2_PAF(k) __builtin_bit_cast(bf16x8, pw##k)
#define A2_GAPA(MF, A0, A1, A2, A3, W0, W1, PW) do { MF; sacc += A0; sacc += A1; sacc += A2; sacc += A3; A2_PIN(sacc); W0; W1; A2_PIN(PW); FA_SBAR(); } while (0)
#define A2_GAPB(MF, X, B) do { MF; X[B] = __builtin_amdgcn_exp2f(X[B]); X[B + 1] = __builtin_amdgcn_exp2f(X[B + 1]); A2_PIN(X); FA_SBAR(); } while (0)
#define A2_KRD(G, j) do { if (G) { A2_KLOAD2(kp0 + sl_next, j); FA_SBAR(); } } while (0)
#define A2_PKW(P, B) cvtpk(P[B], P[B + 1])
#define A2_STEP(C0, C1, P0, P1, t, GK, GV, GL) do { FA_SBAR(); \
        const FA_LAS char* vp_ = vp0 + sl_prev; float sacc = P0[0] + P0[1]; \
        A2_VRD(0, 0); FA_SBAR(); A2_GAPA(C0 = __builtin_amdgcn_mfma_f32_32x32x16_bf16(kf[0], qr[0], ZERO, 0, 0, 0), P0[2], P0[3], P0[4], P0[5],     pw0[0] = A2_PKW(P0, 0), pw0[1] = A2_PKW(P0, 2), pw0); \
        A2_VRD(1, 1); FA_SBAR(); A2_GAPA(C1 = __builtin_amdgcn_mfma_f32_32x32x16_bf16(kf[1], qr[0], ZERO, 0, 0, 0), P0[6], P0[7], P0[8], P0[9],     pw0[2] = A2_PKW(P0, 4), pw0[3] = A2_PKW(P0, 6), pw0); \
        A2_VRD(2, 2); FA_SBAR(); A2_GAPA(C0 = __builtin_amdgcn_mfma_f32_32x32x16_bf16(kf[2], qr[1], C0, 0, 0, 0),   P0[10], P0[11], P0[12], P0[13], pw1[0] = A2_PKW(P0, 8), pw1[1] = A2_PKW(P0, 10), pw1); \
        A2_VRD(3, 3); FA_SBAR(); A2_GAPA(C1 = __builtin_amdgcn_mfma_f32_32x32x16_bf16(kf[3], qr[1], C1, 0, 0, 0),   P0[14], P0[15], P1[0], P1[1],   pw1[2] = A2_PKW(P0, 12), pw1[3] = A2_PKW(P0, 14), pw1); \
        A2_VRD(4, 4); FA_SBAR(); A2_GAPA(C0 = __builtin_amdgcn_mfma_f32_32x32x16_bf16(kf[4], qr[2], C0, 0, 0, 0),   P1[2], P1[3], P1[4], P1[5],     pw2[0] = A2_PKW(P1, 0), pw2[1] = A2_PKW(P1, 2), pw2); \
        A2_VRD(5, 5); FA_SBAR(); A2_GAPA(C1 = __builtin_amdgcn_mfma_f32_32x32x16_bf16(kf[5], qr[2], C1, 0, 0, 0),   P1[6], P1[7], P1[8], P1[9],     pw2[2] = A2_PKW(P1, 4), pw2[3] = A2_PKW(P1, 6), pw2); \
        A2_VRD(6, 6); FA_SBAR(); A2_GAPA(C0 = __builtin_amdgcn_mfma_f32_32x32x16_bf16(kf[6], qr[3], C0, 0, 0, 0),   P1[10], P1[11], P1[12], P1[13], pw3[0] = A2_PKW(P1, 8), pw3[1] = A2_PKW(P1, 10), pw3); \
        A2_VRD(7, 7); FA_SBAR(); A2_GAPA(C1 = __builtin_amdgcn_mfma_f32_32x32x16_bf16(kf[7], qr[3], C1, 0, 0, 0),   P1[14], P1[15], 0.f, 0.f,       pw3[2] = A2_PKW(P1, 12), pw3[3] = A2_PKW(P1, 14), pw3); \
        l_reg += sacc; \
        if (SHIFT) { _Pragma("unroll") for (int r = 0; r < 16; ++r) { C0[r] += negm; C1[r] += negm; } } \
        FA_SBAR(); \
        A2_GAPB(o[0] = __builtin_amdgcn_mfma_f32_32x32x16_bf16(A2_PAF(0), A2_VFR(0), o[0], 0, 0, 0), C0, 0);  A2_VRD(0, 8);  FA_SBAR(); \
        A2_GAPB(o[1] = __builtin_amdgcn_mfma_f32_32x32x16_bf16(A2_PAF(0), A2_VFR(1), o[1], 0, 0, 0), C0, 2);  A2_VRD(1, 9);  FA_SBAR(); \
        A2_GAPB(o[2] = __builtin_amdgcn_mfma_f32_32x32x16_bf16(A2_PAF(0), A2_VFR(2), o[2], 0, 0, 0), C0, 4);  A2_VRD(2, 10); FA_SBAR(); \
        A2_KRD(GL, 0); A2_GAPB(o[3] = __builtin_amdgcn_mfma_f32_32x32x16_bf16(A2_PAF(0), A2_VFR(3), o[3], 0, 0, 0), C0, 6);  A2_VRD(3, 11); FA_SBAR(); \
        A2_GAPB(o[0] = __builtin_amdgcn_mfma_f32_32x32x16_bf16(A2_PAF(1), A2_VFR(4), o[0], 0, 0, 0), C0, 8);  A2_VRD(4, 12); FA_SBAR(); \
        A2_KRD(GL, 1); A2_GAPB(o[1] = __builtin_amdgcn_mfma_f32_32x32x16_bf16(A2_PAF(1), A2_VFR(5), o[1], 0, 0, 0), C0, 10); A2_VRD(5, 13); FA_SBAR(); \
        A2_GAPB(o[2] = __builtin_amdgcn_mfma_f32_32x32x16_bf16(A2_PAF(1), A2_VFR(6), o[2], 0, 0, 0), C0, 12); A2_VRD(6, 14); FA_SBAR(); \
        A2_KRD(GL, 2); A2_GAPB(o[3] = __builtin_amdgcn_mfma_f32_32x32x16_bf16(A2_PAF(1), A2_VFR(7), o[3], 0, 0, 0), C0, 14); A2_VRD(7, 15); FA_SBAR(); \
        if (GK) { A2_DMA_K1((t) + 3, sl_cur, 0); FA_SBAR(); } A2_GAPB(o[0] = __builtin_amdgcn_mfma_f32_32x32x16_bf16(A2_PAF(2), A2_VFR(0), o[0], 0, 0, 0), C1, 0); \
        A2_KRD(GL, 3); A2_GAPB(o[1] = __builtin_amdgcn_mfma_f32_32x32x16_bf16(A2_PAF(2), A2_VFR(1), o[1], 0, 0, 0), C1, 2); \
        if (GK) { A2_DMA_K1((t) + 3, sl_cur, 1); FA_SBAR(); } A2_GAPB(o[2] = __builtin_amdgcn_mfma_f32_32x32x16_bf16(A2_PAF(2), A2_VFR(2), o[2], 0, 0, 0), C1, 4); \
        A2_GAPB(o[3] = __builtin_amdgcn_mfma_f32_32x32x16_bf16(A2_PAF(2), A2_VFR(3), o[3], 0, 0, 0), C1, 6); \
        if (GV) { A2_DMA_V1((t) + 1, sl_next, 0); FA_SBAR(); } A2_GAPB(o[0] = __builtin_amdgcn_mfma_f32_32x32x16_bf16(A2_PAF(3), A2_VFR(4), o[0], 0, 0, 0), C1, 8); \
        A2_GAPB(o[1] = __builtin_amdgcn_mfma_f32_32x32x16_bf16(A2_PAF(3), A2_VFR(5), o[1], 0, 0, 0), C1, 10); \
        if (GV) { A2_DMA_V1((t) + 1, sl_next, 1); FA_SBAR(); } A2_GAPB(o[2] = __builtin_amdgcn_mfma_f32_32x32x16_bf16(A2_PAF(3), A2_VFR(6), o[2], 0, 0, 0), C1, 12); \
        A2_GAPB(o[3] = __builtin_amdgcn_mfma_f32_32x32x16_bf16(A2_PAF(3), A2_VFR(7), o[3], 0, 0, 0), C1, 14); \
    } while (0)
    A2_DMA_K(0, 0); A2_DMA_V(0, 0); A2_DMA_K(1, 16384); A2_DMA_K(2, 32768);
    A2_WBAR(6);
    {
        const FA_LAS char* kp_ = kp0;
#pragma unroll
        for (int d0 = 0; d0 < 4; ++d0) {
            const bf16x8 b0_ = *(const FA_LAS bf16x8*)(kp_ + d0 * 2048), b1_ = *(const FA_LAS bf16x8*)(kp_ + d0 * 2048 + 512);
            if (d0 == 0) { pA0 = __builtin_amdgcn_mfma_f32_32x32x16_bf16(b0_, qr[0], ZERO, 0, 0, 0); pA1 = __builtin_amdgcn_mfma_f32_32x32x16_bf16(b1_, qr[0], ZERO, 0, 0, 0); }
            else { pA0 = __builtin_amdgcn_mfma_f32_32x32x16_bf16(b0_, qr[d0], pA0, 0, 0, 0); pA1 = __builtin_amdgcn_mfma_f32_32x32x16_bf16(b1_, qr[d0], pA1, 0, 0, 0); }
        }
        if (SHIFT) {
#pragma unroll
            for (int r = 0; r < 16; ++r) { pA0[r] += negm; pA1[r] += negm; }
        }
#pragma unroll
        for (int r = 0; r < 16; ++r) { pA0[r] = __builtin_amdgcn_exp2f(pA0[r]); pA1[r] = __builtin_amdgcn_exp2f(pA1[r]); }
    }
    A2_WBAR(0);
    A2_DMA_K(3, 0); A2_DMA_V(1, 16384);
    A2_ROT();
    A2_KLOAD2(kp0 + sl_cur, 0); A2_KLOAD2(kp0 + sl_cur, 1); A2_KLOAD2(kp0 + sl_cur, 2); A2_KLOAD2(kp0 + sl_cur, 3);
    A2_WBAR(4);
    int t = 1;
    for (; t + 5 < NT; t += 2) {
        A2_STEP(pB0, pB1, pA0, pA1, t, true, true, true);     A2_WBAR(4); A2_ROT();
        A2_STEP(pA0, pA1, pB0, pB1, t + 1, true, true, true); A2_WBAR(4); A2_ROT();
    }
#define A2_ENDW(tt) do { if ((tt) + 3 < NT) { A2_WBAR(4); } else if ((tt) + 2 < NT) { A2_WBAR(2); } else { A2_WBAR(0); } } while (0)
    for (; t + 1 < NT; t += 2) {
        A2_STEP(pB0, pB1, pA0, pA1, t, (t + 3 < NT), (t + 1 < NT), (t + 1 < NT));         A2_ENDW(t);     A2_ROT();
        A2_STEP(pA0, pA1, pB0, pB1, t + 1, (t + 4 < NT), (t + 2 < NT), (t + 2 < NT));     A2_ENDW(t + 1); A2_ROT();
    }
    A2_STEP(pB0, pB1, pA0, pA1, NT - 1, false, false, false);
    {
        float sacc = pB0[0] + pB0[1];
#pragma unroll
        for (int r = 2; r < 16; ++r) sacc += pB0[r];
#pragma unroll
        for (int r = 0; r < 16; ++r) sacc += pB1[r];
        l_reg += sacc;
        pw0 = (u32x4){A2_PKW(pB0, 0), A2_PKW(pB0, 2), A2_PKW(pB0, 4), A2_PKW(pB0, 6)}; pw1 = (u32x4){A2_PKW(pB0, 8), A2_PKW(pB0, 10), A2_PKW(pB0, 12), A2_PKW(pB0, 14)};
        pw2 = (u32x4){A2_PKW(pB1, 0), A2_PKW(pB1, 2), A2_PKW(pB1, 4), A2_PKW(pB1, 6)}; pw3 = (u32x4){A2_PKW(pB1, 8), A2_PKW(pB1, 10), A2_PKW(pB1, 12), A2_PKW(pB1, 14)};
        const FA_LAS char* vp_ = vp0 + sl_cur;
#pragma unroll
        for (int d0 = 0; d0 < 4; ++d0) {
            const s16x4 l0_ = vtr(vp_ + d0 * 4096), h0_ = vtr(vp_ + d0 * 4096 + 512), l1_ = vtr(vp_ + d0 * 4096 + 1024), h1_ = vtr(vp_ + d0 * 4096 + 1536);
            const s16x4 l2_ = vtr(vp_ + d0 * 4096 + 2048), h2_ = vtr(vp_ + d0 * 4096 + 2560), l3_ = vtr(vp_ + d0 * 4096 + 3072), h3_ = vtr(vp_ + d0 * 4096 + 3584);
            o[d0] = __builtin_amdgcn_mfma_f32_32x32x16_bf16(A2_PAF(0), FA_PKF(l0_, h0_), o[d0], 0, 0, 0);
            o[d0] = __builtin_amdgcn_mfma_f32_32x32x16_bf16(A2_PAF(1), FA_PKF(l1_, h1_), o[d0], 0, 0, 0);
            o[d0] = __builtin_amdgcn_mfma_f32_32x32x16_bf16(A2_PAF(2), FA_PKF(l2_, h2_), o[d0], 0, 0, 0);
            o[d0] = __builtin_amdgcn_mfma_f32_32x32x16_bf16(A2_PAF(3), FA_PKF(l3_, h3_), o[d0], 0, 0, 0);
        }
    }
    { auto rr = __builtin_amdgcn_permlane32_swap(__float_as_uint(l_reg), __float_as_uint(l_reg), false, false); l_reg = __uint_as_float(rr[0]) + __uint_as_float(rr[1]); }
    if (hi == 0) wsf[r32] = 1.f / l_reg;
    asm volatile("s_waitcnt lgkmcnt(0)" ::: "memory");
    __syncthreads();
    unsigned* X = (unsigned*)lds + (wq * 32) * 64 + lane;
    if (sidx == 1) {
#pragma unroll
        for (int r = 0; r < 16; ++r) { const float il = wsf[crow(r, hi)];
            X[(0 * 16 + r) * 64] = cvtpk(o[0][r] * il, o[1][r] * il); X[(1 * 16 + r) * 64] = cvtpk(o[2][r] * il, o[3][r] * il); }
    }
    __syncthreads();
    if (sidx == 0) {
        const unsigned oo = ((unsigned)(qrow0 + 4 * hi) * DM + 128 * h + 4 * r32) * 2u;
        const float g0 = dnorm[r32], g1 = dnorm[32 + r32], g2 = dnorm[64 + r32], g3 = dnorm[96 + r32];
        float* SS = (float*)(lds + 32768) + wq * 1024 + hi * 512;
        float* TOT = (float*)(lds + 49152) + wq * 32 + hi * 16;
#pragma unroll
        for (int r = 0; r < 16; ++r) {
            const float il = wsf[crow(r, hi)];
            const unsigned w0 = X[(0 * 16 + r) * 64], w1 = X[(1 * 16 + r) * 64];
            const float v0 = o[0][r] * il - lam * __uint_as_float(w0 << 16), v1 = o[1][r] * il - lam * __uint_as_float(w0 & 0xffff0000u);
            const float v2 = o[2][r] * il - lam * __uint_as_float(w1 << 16), v3 = o[3][r] * il - lam * __uint_as_float(w1 & 0xffff0000u);
            o[0][r] = v0; o[1][r] = v1; o[2][r] = v2; o[3][r] = v3;
            SS[r * 32 + r32] = v0 * v0 + v1 * v1 + v2 * v2 + v3 * v3;
        }
        {
            const f32x4* rp = (const f32x4*)(SS + (r32 & 15) * 32 + (r32 >> 4) * 16);
            const f32x4 a = rp[0], bq = rp[1], c4 = rp[2], d4 = rp[3];
            float t = ((a[0] + a[1]) + (a[2] + a[3])) + ((bq[0] + bq[1]) + (bq[2] + bq[3])) + ((c4[0] + c4[1]) + (c4[2] + c4[3])) + ((d4[0] + d4[1]) + (d4[2] + d4[3]));
            t += __shfl_xor(t, 16);
            if (r32 < 16) TOT[r32] = t;
        }
        const f32x4 t0 = *(const f32x4*)(TOT), t1 = *(const f32x4*)(TOT + 4), t2 = *(const f32x4*)(TOT + 8), t3 = *(const f32x4*)(TOT + 12);
#pragma unroll
        for (int r = 0; r < 16; ++r) {
            const float ss = (r < 4 ? t0 : r < 8 ? t1 : r < 12 ? t2 : t3)[r & 3];
            const float rs = rsqrtf(ss * (1.f / 128.f) + EPS) * (1.f - LAM_INIT);
            u32x2 w; w.x = cvtpk(o[0][r] * rs * g0, o[1][r] * rs * g1); w.y = cvtpk(o[2][r] * rs * g2, o[3][r] * rs * g3);
            *(u32x2*)((char*)OBN + oo + (unsigned)((r & 3) + 8 * (r >> 2)) * (DM * 2u)) = w;
        }
    }
    __syncthreads();
}
}


typedef float f32x2h_t __attribute__((ext_vector_type(2))); typedef __bf16 bf16x2h_t __attribute__((ext_vector_type(2)));
__device__ __forceinline__ unsigned pk2_hw(float lo, float hi) { f32x2h_t v = {lo, hi}; bf16x2h_t bb = __builtin_convertvector(v, bf16x2h_t); return __builtin_bit_cast(unsigned, bb); }
__device__ __forceinline__ unsigned f2bf_hw(float f) { return pk2_hw(f, 0.f) & 0xffffu; }
__device__ __forceinline__ void p2a_logdecay(const Params& p, unsigned char* smem, int wv) {
    typedef float f32x16p __attribute__((ext_vector_type(16))); typedef short bf16x8p __attribute__((ext_vector_type(8)));
    int tid = GET_TID(wv); asm volatile("" : "+v"(tid));
    const int lane = tid & 63, r32 = lane & 31, hi = lane >> 5;
    const float* LR = (const float*)(p.ws + WS_LR);
    bf16_t* LAT = (bf16_t*)(p.ws + WS_LAT);
    (void)smem;
    for (int combo = blockIdx.x; combo < 256; combo += gridDim.x) {
        const int u = combo >> 3, tile = combo & 7, rb = tile & 1, cb = tile >> 1, dir = u & 1, h = (u >> 1) & 3, b = u >> 3;
        const int ca = 32 * cb + r32;
        bf16x8p whi, wlo;
#pragma unroll
        for (int j = 0; j < 8; ++j) { const float w = p.w_dec[(size_t)(dir * 16 + 8 * hi + j) * 512 + 128 * h + ca];
            const unsigned wh = f2bf_hw(w); const float rem = w - __uint_as_float(wh << 16); whi[j] = (short)wh; wlo[j] = (short)f2bf_hw(rem); }
        const float bdec = p.b_dec[dir * 512 + 128 * h + ca];
#define P2A_ROW(n_) ((n_) < 4 ? NLAT + b * CTXL + (dir ? CTXL - 1 - (64 * (n_) + 32 * rb + r32) : 64 * (n_) + 32 * rb + r32) \
                              : b * SEQ + (dir ? SEQ - 1 - (64 * ((n_) - 4) + 32 * rb + r32) : 64 * ((n_) - 4) + 32 * rb + r32))
        f32x4 an0 = {0.f, 0.f, 0.f, 0.f}, an1 = an0;
        if (wv < 132) { const float* ap = LR + (size_t)P2A_ROW(wv) * 32 + 16 * dir + 8 * hi; an0 = *(const f32x4*)ap; an1 = *(const f32x4*)(ap + 4); }
        for (int n = wv; n < 132; n += 8) {
            const f32x4 a0 = an0, a1 = an1;
            if (n + 8 < 132) { const float* ap = LR + (size_t)P2A_ROW(n + 8) * 32 + 16 * dir + 8 * hi; an0 = *(const f32x4*)ap; an1 = *(const f32x4*)(ap + 4); }
            bf16x8p ahi, alo;
#pragma unroll
            for (int j = 0; j < 8; ++j) { const float x = j < 4 ? a0[j] : a1[j - 4]; const unsigned xh = f2bf_hw(x); const float rem = x - __uint_as_float(xh << 16); ahi[j] = (short)xh; alo[j] = (short)f2bf_hw(rem); }
            f32x16p acc = {};
            acc = __builtin_amdgcn_mfma_f32_32x32x16_bf16(alo, whi, acc, 0, 0, 0);
            acc = __builtin_amdgcn_mfma_f32_32x32x16_bf16(ahi, wlo, acc, 0, 0, 0);
            acc = __builtin_amdgcn_mfma_f32_32x32x16_bf16(ahi, whi, acc, 0, 0, 0);
            unsigned pk[8];
#pragma unroll
            for (int g = 0; g < 4; ++g) {
                float l4[4];
#pragma unroll
                for (int e = 0; e < 4; ++e) { const float z = acc[4 * g + e] + bdec; l4[e] = (fminf(z, 0.f) - __logf(1.f + __expf(-fabsf(z)))) * (1.f / 16.f); }
                pk[2 * g] = pk2_hw(l4[0], l4[1]); pk[2 * g + 1] = pk2_hw(l4[2], l4[3]);
            }
            bf16_t* dst = LAT + ((size_t)((u * 132 + n) * 128 + ca) * 64 + 32 * rb + 8 * hi);
#pragma unroll
            for (int gp = 0; gp < 2; ++gp) {
                const auto s0 = __builtin_amdgcn_permlane32_swap(pk[4 * gp], pk[4 * gp + 2], false, false), s1 = __builtin_amdgcn_permlane32_swap(pk[4 * gp + 1], pk[4 * gp + 3], false, false);
                *(u32x4*)(dst + 16 * gp) = (u32x4){s0[0], s1[0], s0[1], s1[1]};
            }
        }
#undef P2A_ROW
    }
}

namespace fg {
using fa::bf16x8; using fa::s16x4; using fa::f32x16; using fa::crow; using fa::cvtpk;
typedef short v4i16_t __attribute__((ext_vector_type(4)));
typedef __attribute__((address_space(3))) const char* lds_cptr;
#define FG_LAS __attribute__((address_space(3)))
constexpr int L_LR = 0;
constexpr int L_GT = 4096;
constexpr int L_ER = 6144, L_EL = 6656, L_DEC = 7168;
constexpr int L_E1 = 8192;
constexpr int L_P = L_E1;
constexpr int QSTR = 272, PSTR = 144;
constexpr int L_QS = 40960, L_KS = 58368, L_QI = 75776;
constexpr int L_KST = 93184;
constexpr int L_VS = 109568;
constexpr int L_WD = 142336;
constexpr int L_BD = L_WD + 8192;
constexpr int L_END = L_BD + 512;
__device__ __forceinline__ s16x4 vtr(lds_cptr p) { return __builtin_bit_cast(s16x4, __builtin_amdgcn_ds_read_tr16_b64_v4i16((FG_LAS v4i16_t*)p)); }
__device__ __forceinline__ bf16x8 ldb128(lds_cptr p) { return *(const FG_LAS bf16x8*)p; }
__device__ __forceinline__ int rowmap(int b, int dir, int n, int i) {
    if (n < 4) { const int idx = 64 * n + i; return NLAT + b * CTXL + (dir ? CTXL - 1 - idx : idx); }
    const int idx = 64 * (n - 4) + i; return b * SEQ + (dir ? SEQ - 1 - idx : idx);
}
#define FG_PKF(L, H) (bf16x8){L[0], L[1], L[2], L[3], H[0], H[1], H[2], H[3]}

#define FG_LBAR() asm volatile("s_waitcnt lgkmcnt(0)\n\ts_barrier" ::: "memory")
__device__ __forceinline__ void gla_unit(const Params& p, int b, int h, int dir, unsigned char* smem, int wv) {
    int tid = GET_TID(wv); asm volatile("" : "+v"(tid));
    const int lane = tid & 63, wid = tid >> 6, r32 = lane & 31, hi = lane >> 5;
    const int ca = tid & 127, tg = tid >> 7;
    const int ib = tid >> 3, cg = tid & 7;
    FG_LAS char* L = (FG_LAS char*)smem;
    const char* GQ = (const char*)(p.ws + WS_GQ); const char* GK = (const char*)(p.ws + WS_GK); const char* GV = (const char*)(p.ws + WS_GV);
    const char* LR = (const char*)(p.ws + WS_LR);
    bf16_t* OUT = (bf16_t*)p.out + (size_t)dir * NLAT * DM;
    const char* LATu = (const char*)(p.ws + WS_LAT) + ((size_t)((b * 8 + h * 2 + dir) * 132) * 128 * 64 + (size_t)ca * 64 + 16 * tg) * 2;
    f32x16 S[4];
#pragma unroll
    for (int t = 0; t < 4; ++t) S[t] = f32x16{};
    u32x4 pq0, pq1, pk0, pk1, pv0, pv1, pv2, pv3, pla0, pla1;
#define FG_PREFETCH_QK(n) do { const unsigned row_ = (unsigned)rowmap(b, dir, (n), ib); \
        const char* qp_ = GQ + (row_ * 512u + 128u * h + 16u * cg) * 2u; pq0 = *(const u32x4*)qp_; pq1 = *(const u32x4*)(qp_ + 16); \
        const char* kp_ = GK + (row_ * 512u + 128u * h + 16u * cg) * 2u; pk0 = *(const u32x4*)kp_; pk1 = *(const u32x4*)(kp_ + 16); } while (0)
#define FG_PREFETCH_V(n) do { const unsigned row_ = (unsigned)rowmap(b, dir, (n), ib); \
        const char* vp_ = GV + (row_ * 1024u + 256u * h + 32u * cg) * 2u; pv0 = *(const u32x4*)vp_; pv1 = *(const u32x4*)(vp_ + 16); pv2 = *(const u32x4*)(vp_ + 32); pv3 = *(const u32x4*)(vp_ + 48); \
        const char* lp_ = LATu + (size_t)(n) * (128 * 64 * 2); pla0 = *(const u32x4*)lp_; pla1 = *(const u32x4*)(lp_ + 16); } while (0)
    FG_PREFETCH_QK(0); FG_PREFETCH_V(0);
    const int vimg = L_VS + (wid >> 2) * 16384 + (wid & 3) * 512 + fa::v_rd_base(lane);
    const int kstb = L_KST + fa::v_rd_base(lane);
    const int fbase = r32 * QSTR + 16 * hi, qibase = r32 * QSTR + 8 * hi, pwbase = 4 * hi * PSTR + 2 * r32, prbase = r32 * PSTR + 16 * hi;
    for (int n = 0; n < 132; ++n) {
        float cum[16];
        {
            const unsigned lw[8] = {pla0.x, pla0.y, pla0.z, pla0.w, pla1.x, pla1.y, pla1.z, pla1.w};
            float run = 0.f;
#pragma unroll
            for (int i2 = 0; i2 < 8; ++i2) {
                run += __uint_as_float(lw[i2] << 16); cum[2 * i2] = run;
                run += __uint_as_float(lw[i2] & 0xffff0000u); cum[2 * i2 + 1] = run;
            }
            *(FG_LAS float*)(L + L_GT + (tg * 128 + ca) * 4) = run;
        }
        FG_LBAR();
        {
            const float g0 = *(const FG_LAS float*)(L + L_GT + ca * 4), g1 = *(const FG_LAS float*)(L + L_GT + (128 + ca) * 4);
            const float g2 = *(const FG_LAS float*)(L + L_GT + (256 + ca) * 4), g3 = *(const FG_LAS float*)(L + L_GT + (384 + ca) * 4);
            const float ref = g0 + g1, last = (g0 + g1) + (g2 + g3);
            const float off = tg == 0 ? 0.f : tg == 1 ? g0 : tg == 2 ? g0 + g1 : (g0 + g1) + g2;
#pragma unroll
            for (int i = 0; i < 16; ++i) *(FG_LAS float*)(L + L_E1 + ((16 * tg + i) * 128 + ca) * 4) = __expf(cum[i] + off - ref);
            if (tg == 0) { *(FG_LAS float*)(L + L_ER + ca * 4) = __expf(ref); *(FG_LAS float*)(L + L_EL + ca * 4) = __expf(last - ref); *(FG_LAS float*)(L + L_DEC + ca * 4) = __expf(last); }
        }
        FG_LBAR();
        {
            { const int img = cg >> 2, cb = 32 * (cg & 3);
              *(FG_LAS u32x4*)(L + L_VS + img * 16384 + fa::v_st(ib, cb)) = pv0; *(FG_LAS u32x4*)(L + L_VS + img * 16384 + fa::v_st(ib, cb + 8)) = pv1;
              *(FG_LAS u32x4*)(L + L_VS + img * 16384 + fa::v_st(ib, cb + 16)) = pv2; *(FG_LAS u32x4*)(L + L_VS + img * 16384 + fa::v_st(ib, cb + 24)) = pv3; }
            unsigned qs[8], ks[8], qi[8], kt[8];
            const unsigned qw[8] = {pq0.x, pq0.y, pq0.z, pq0.w, pq1.x, pq1.y, pq1.z, pq1.w};
            const unsigned kw[8] = {pk0.x, pk0.y, pk0.z, pk0.w, pk1.x, pk1.y, pk1.z, pk1.w};
#pragma unroll
            for (int q4 = 0; q4 < 4; ++q4) {
                const f32x4 e1 = *(const FG_LAS f32x4*)(L + L_E1 + (ib * 128 + 16 * cg + 4 * q4) * 4);
                const f32x4 er = *(const FG_LAS f32x4*)(L + L_ER + (16 * cg + 4 * q4) * 4), el = *(const FG_LAS f32x4*)(L + L_EL + (16 * cg + 4 * q4) * 4);
#pragma unroll
                for (int e = 0; e < 2; ++e) {
                    const int wi = 2 * q4 + e;
                    const float qa = __uint_as_float(qw[wi] << 16), qb = __uint_as_float(qw[wi] & 0xffff0000u);
                    const float ka = __uint_as_float(kw[wi] << 16), kb = __uint_as_float(kw[wi] & 0xffff0000u);
                    const float ea = e1[2 * e], eb = e1[2 * e + 1];
                    const float ia = __builtin_amdgcn_rcpf(ea), ibv = __builtin_amdgcn_rcpf(eb);
                    const float qsa = qa * ea, qsb = qb * eb, ksa = ka * ia, ksb = kb * ibv;
                    qs[wi] = cvtpk(qsa, qsb); ks[wi] = cvtpk(ksa, ksb);
                    qi[wi] = cvtpk(qsa * er[2 * e], qsb * er[2 * e + 1]); kt[wi] = cvtpk(ksa * el[2 * e], ksb * el[2 * e + 1]);
                }
            }
            const int c0 = ib * QSTR + 32 * cg, c1 = c0 + 16;
            *(FG_LAS u32x4*)(L + L_QS + c0) = (u32x4){qs[0], qs[1], qs[2], qs[3]}; *(FG_LAS u32x4*)(L + L_QS + c1) = (u32x4){qs[4], qs[5], qs[6], qs[7]};
            *(FG_LAS u32x4*)(L + L_KS + c0) = (u32x4){ks[0], ks[1], ks[2], ks[3]}; *(FG_LAS u32x4*)(L + L_KS + c1) = (u32x4){ks[4], ks[5], ks[6], ks[7]};
            *(FG_LAS u32x4*)(L + L_QI + c0) = (u32x4){qi[0], qi[1], qi[2], qi[3]}; *(FG_LAS u32x4*)(L + L_QI + c1) = (u32x4){qi[4], qi[5], qi[6], qi[7]};
            *(FG_LAS u32x4*)(L + L_KST + fa::v_st(ib, 16 * cg)) = (u32x4){kt[0], kt[1], kt[2], kt[3]};
            *(FG_LAS u32x4*)(L + L_KST + fa::v_st(ib, 16 * cg + 8)) = (u32x4){kt[4], kt[5], kt[6], kt[7]};
        }
        FG_LBAR();
        if (n + 1 < 132) FG_PREFETCH_V(n + 1);
        if (wid < 3) {
            const int it = wid == 0 ? 0 : 1, jt = wid == 2 ? 1 : 0;
            f32x16 sc = f32x16{};
#pragma unroll
            for (int k4 = 0; k4 < 2; ++k4) {
                bf16x8 av[4], bv[4];
#pragma unroll
                for (int ks = 0; ks < 4; ++ks) { av[ks] = ldb128((lds_cptr)(L + L_QS + fbase + it * (32 * QSTR) + 32 * (4 * k4 + ks))); bv[ks] = ldb128((lds_cptr)(L + L_KS + fbase + jt * (32 * QSTR) + 32 * (4 * k4 + ks))); }
#pragma unroll
                for (int ks = 0; ks < 4; ++ks) sc = __builtin_amdgcn_mfma_f32_32x32x16_bf16(av[ks], bv[ks], sc, 0, 0, 0);
            }
#pragma unroll
            for (int r = 0; r < 16; ++r) {
                const int i = crow(r, hi);
                float v = sc[r]; if (it == jt && r32 > i) v = 0.f;
                *(FG_LAS bf16_t*)(L + L_P + pwbase + (32 * it + (r & 3) + 8 * (r >> 2)) * PSTR + 64 * jt) = (bf16_t)f2bf(v);
            }
        }
        bf16x8 vf[4];
#pragma unroll
        for (int ks = 0; ks < 4; ++ks) { const s16x4 lo = vtr((lds_cptr)(L + vimg + ks * 4096)), hh = vtr((lds_cptr)(L + vimg + ks * 4096 + 2048)); vf[ks] = FG_PKF(lo, hh); }
        f32x16 o0 = f32x16{}, o1 = f32x16{};
#pragma unroll
        for (int t = 0; t < 4; ++t) {
            u32x2 qa[2][2], qb[2][2];
#pragma unroll
            for (int s2 = 0; s2 < 2; ++s2) { const int ch = (4 * t + 2 * s2) * 16;
                qa[s2][0] = *(const FG_LAS u32x2*)(L + L_QI + qibase + ch); qa[s2][1] = *(const FG_LAS u32x2*)(L + L_QI + qibase + ch + 16);
                qb[s2][0] = *(const FG_LAS u32x2*)(L + L_QI + qibase + 32 * QSTR + ch); qb[s2][1] = *(const FG_LAS u32x2*)(L + L_QI + qibase + 32 * QSTR + ch + 16); }
#pragma unroll
            for (int s2 = 0; s2 < 2; ++s2) {
                u32x4 sw; sw.x = cvtpk(S[t][8 * s2 + 0], S[t][8 * s2 + 1]); sw.y = cvtpk(S[t][8 * s2 + 2], S[t][8 * s2 + 3]);
                sw.z = cvtpk(S[t][8 * s2 + 4], S[t][8 * s2 + 5]); sw.w = cvtpk(S[t][8 * s2 + 6], S[t][8 * s2 + 7]);
                const bf16x8 sb = __builtin_bit_cast(bf16x8, sw);
                { const u32x4 aw = {qa[s2][0].x, qa[s2][0].y, qa[s2][1].x, qa[s2][1].y}; o0 = __builtin_amdgcn_mfma_f32_32x32x16_bf16(__builtin_bit_cast(bf16x8, aw), sb, o0, 0, 0, 0); }
                { const u32x4 aw = {qb[s2][0].x, qb[s2][0].y, qb[s2][1].x, qb[s2][1].y}; o1 = __builtin_amdgcn_mfma_f32_32x32x16_bf16(__builtin_bit_cast(bf16x8, aw), sb, o1, 0, 0, 0); }
            }
        }
#pragma unroll
        for (int t = 0; t < 4; ++t) {
            s16x4 klo[4], khi[4];
#pragma unroll
            for (int ks = 0; ks < 4; ++ks) { klo[ks] = vtr((lds_cptr)(L + kstb + t * 512 + ks * 4096)); khi[ks] = vtr((lds_cptr)(L + kstb + t * 512 + ks * 4096 + 2048)); }
#pragma unroll
            for (int g = 0; g < 4; ++g) {
                const f32x4 dc = *(const FG_LAS f32x4*)(L + L_DEC + (32 * t + 8 * g + 4 * hi) * 4);
                S[t][4 * g + 0] *= dc[0]; S[t][4 * g + 1] *= dc[1]; S[t][4 * g + 2] *= dc[2]; S[t][4 * g + 3] *= dc[3];
            }
#pragma unroll
            for (int ks = 0; ks < 4; ++ks) S[t] = __builtin_amdgcn_mfma_f32_32x32x16_bf16(FG_PKF(klo[ks], khi[ks]), vf[ks], S[t], 0, 0, 0);
        }
        FG_LBAR();
        if (n + 1 < 132) FG_PREFETCH_QK(n + 1);
#pragma unroll
        for (int ks = 0; ks < 2; ++ks) {
            const bf16x8 a = ldb128((lds_cptr)(L + L_P + prbase + 32 * ks));
            o0 = __builtin_amdgcn_mfma_f32_32x32x16_bf16(a, vf[ks], o0, 0, 0, 0);
        }
#pragma unroll
        for (int ks = 0; ks < 4; ++ks) {
            const bf16x8 a = ldb128((lds_cptr)(L + L_P + prbase + 32 * PSTR + 32 * ks));
            o1 = __builtin_amdgcn_mfma_f32_32x32x16_bf16(a, vf[ks], o1, 0, 0, 0);
        }
        if (n >= 4) {
            const int i0 = 64 * (n - 4) + 4 * hi;
            const int rstep = dir ? -(DM * 2) : (DM * 2);
            const unsigned ob = ((unsigned)(b * SEQ + (dir ? SEQ - 1 - i0 : i0)) * DM + 256 * h + 32 * wid + r32) * 2u;
            char* OC = (char*)OUT;
#pragma unroll
            for (int r = 0; r < 16; ++r) {
                const int k = (r & 3) + 8 * (r >> 2);
                *(bf16_t*)(OC + (ob + (unsigned)(rstep * k))) = (bf16_t)f2bf(o0[r]);
                *(bf16_t*)(OC + (ob + (unsigned)(rstep * (k + 32)))) = (bf16_t)f2bf(o1[r]);
            }
        }
    }
#undef FG_PREFETCH_QK
#undef FG_PREFETCH_V
    __syncthreads();
}
}

template <bool LATE> __device__ __forceinline__ void p0_weights(const Params& p, unsigned char* smem, int wv);
__device__ __forceinline__ void p2_mixed(const Params& p, unsigned char* smem, int wv) {
#ifndef SK3G
    if (blockIdx.x < 32) { const int u = (int)blockIdx.x; fg::gla_unit(p, u >> 3, (u >> 1) & 3, u & 1, smem, wv);
#if PROBE == 3
        fg::gla_unit(p, u >> 3, (u >> 1) & 3, u & 1, smem, wv);
#endif
    }
#endif
#if PROBE == 6
    if (blockIdx.x < 32) return;
#endif
#ifndef SK3B
    unsigned* ctr = (unsigned*)(p.ws + WS_CTR);
    FG_LAS unsigned* slot = (FG_LAS unsigned*)(smem + LDS_BYTES - 64);
    const float lam = __uint_as_float(__builtin_amdgcn_readfirstlane(__float_as_uint(lam_value(p.dlam))));
    const float negm = __uint_as_float(__builtin_amdgcn_readfirstlane(__float_as_uint(-attn_shift(p.qn, p.kn))));
    bf16_t* DQ = (bf16_t*)(p.ws + WS_DQ); const bf16_t* DK = (const bf16_t*)(p.ws + WS_DK); const bf16_t* DV = (const bf16_t*)(p.ws + WS_DV);
    const unsigned myx = xb_xcc_id() & 7u;
    for (unsigned qi = 0; qi < 8u; ++qi) {
        const unsigned x = (myx + qi) & 7u;
        for (;;) {
            if (wv == 0 && lane_id() == 0) *slot = atomicAdd(ctr + 16 * x, 1u);
            __syncthreads();
            const unsigned i = __builtin_amdgcn_readfirstlane(*slot);
            __syncthreads();
            if (i >= 256u) break;
            const unsigned bh = 4u * x + (i >> 6);
            const int ab = (int)(bh >> 3), ah = (int)(bh & 7), aq = (int)(i & 63);
            if (negm > -64.f) fa::attn_unit2<false>(ab, ah, aq, DQ, DQ, DK, DV, p.dnorm, lam, negm, (char*)smem, wv);
            else fa::attn_unit2<true>(ab, ah, aq, DQ, DQ, DK, DV, p.dnorm, lam, negm, (char*)smem, wv);
        }
    }
#endif
    p0_weights<true>(p, smem, wv);
}

namespace pg8 {
#define PG8_LAS __attribute__((address_space(3)))
typedef unsigned short bf16_t;
typedef short bf16x8 __attribute__((ext_vector_type(8)));
typedef float f32x4 __attribute__((ext_vector_type(4)));
typedef unsigned u32x4 __attribute__((ext_vector_type(4)));
constexpr int BM = 256, BK = 64, HALF = 128, HTB = HALF * BK * 2  , STAGE_BYTES = 8 * HTB, NXCD = 8, WGM = 8;

__host__ __device__ __forceinline__ int lds_byte(int r, int c) { const int st = (r >> 4) * 2 + (c >> 5), rr = r & 15, cc = c & 31, ob = rr * 64 + cc * 2; return st * 1024 + (ob ^ (((ob >> 9) & 1) << 5)); }
__host__ __device__ __forceinline__ void stage_rc(int b, int& R, int& C) { const int st = b / 1024, sb = b % 1024, swz = sb ^ (((sb >> 9) & 1) << 5); R = (st >> 1) * 16 + swz / 64; C = (st & 1) * 32 + (swz % 64) / 2; }
__host__ __device__ __forceinline__ int perm32(int rho) { const int n = rho >> 4, i = rho & 15; return 8 * (i >> 2) + 4 * n + (i & 3); }

struct Unit { int pm, pn, w; };
struct Gemm { const bf16_t* A; const bf16_t* Bt; int M, N, K; const bf16_t* A2; const bf16_t* Bt2; };

struct StaticOrder {
    int nM, nN, nwg, G, c;
    __host__ __device__ void init(int M, int N, int G_, int c_) { nM = M / BM; nN = N / BM; nwg = nM * nN; G = G_; c = c_; }
    __host__ __device__ bool next(int i, Unit& u) const {
        const long L = (long)i * G + c; if (L >= nwg) return false;
        int wgid = (int)L; { const int q = nwg / NXCD, r = nwg % NXCD, xcd = wgid % NXCD, off = wgid / NXCD; wgid = (xcd < r ? xcd * (q + 1) : r * (q + 1) + (xcd - r) * q) + off; }
        const int nig = WGM * nN, gid = wgid / nig, fm = gid * WGM, gsz = (nM - fm) < WGM ? (nM - fm) : WGM;
        u.pm = fm + ((wgid % nig) % gsz); u.pn = (wgid % nig) / gsz; u.w = 0; return true;
    }
    __device__ __forceinline__ void a_ready(const Unit&) const {}
    __device__ __forceinline__ void done(const Unit&) const {}
};
struct DualOrder {
    StaticOrder base;
    __device__ void init(int M, int N, int G_, int c_) { base.init(M, N, G_, c_); }
    __device__ bool next(int i, Unit& u) const { const bool ok = base.next(i >> 1, u); u.w = i & 1; return ok; }
    __device__ __forceinline__ void a_ready(const Unit&) const {}
    __device__ __forceinline__ void done(const Unit&) const {}
};
template <class T, class = void> struct is_chain { static constexpr bool value = false; };
template <class T> struct is_chain<T, decltype((void)T::CHAIN)> { static constexpr bool value = true; };

struct MixOrder : StaticOrder {
    __host__ __device__ bool next(int i, Unit& u) const {
        if (!StaticOrder::next(i, u)) return false;
        const int q = u.pn & 3, r = u.pn >> 2; u.pn = 4 * ((q + r) & 3) + r; return true;
    }
};

typedef float f32x2c_t __attribute__((ext_vector_type(2))); typedef __bf16 bf16x2c_t __attribute__((ext_vector_type(2)));
__device__ __forceinline__ unsigned cvt_pk_bf16(float lo, float hi) { f32x2c_t v = {lo, hi}; bf16x2c_t bb = __builtin_convertvector(v, bf16x2c_t); return __builtin_bit_cast(unsigned, bb); }
template <class Epi, class Sched, bool ALIGN_EPI = false, bool SP2 = false>
__device__ __forceinline__ void gemm_phase(PG8_LAS unsigned char* lds, const Gemm g, const Sched& S, const Epi& E, int wv) {
    const int tid = GET_TID(wv), wid = wv, lane = tid & 63, wr = wid >> 2, wc = wid & 3, fr = lane & 15, fq = lane >> 4;
    const int K = g.K, nt = K / BK;
    unsigned voffA[2], voffB[2];
#pragma unroll
    for (int i = 0; i < 2; ++i) { int R, C; stage_rc(tid * 16 + i * 8192, R, C); const int Rb = Epi::PERM ? ((R & ~31) + perm32(R & 31)) : R;
        voffA[i] = (unsigned)(R * K + C) * 2u; voffB[i] = (unsigned)(Rb * K + C) * 2u; }
    const size_t kstep = (size_t)(BK * 2);
    const size_t hstep = (size_t)HALF * K * 2;
    const size_t tstep = 2 * hstep;
    const unsigned ldsw = (unsigned)wid * 1024u;
    const int aoff = lds_byte(wr * 64 + fr, fq * 8), boff = lds_byte(wc * 32 + fr, fq * 8);
#define PG8_SA(b, h) (((b) * 2 + (h)) * HTB)
#define PG8_SB(b, h) ((4 + (b) * 2 + (h)) * HTB)
#define PG8_STAGE(bufoff, gbase, voff) do { _Pragma("unroll") for (int _i = 0; _i < 2; ++_i) \
        __builtin_amdgcn_global_load_lds((const unsigned*)((const char*)(gbase) + (voff)[_i]), (PG8_LAS unsigned*)(lds + (bufoff) + ldsw + _i * 8192), 16, 0, 0); } while (0)
#define PG8_LDA(dst, b, h) do { _Pragma("unroll") for (int m = 0; m < 4; ++m) _Pragma("unroll") for (int k = 0; k < 2; ++k) dst[m][k] = *(const PG8_LAS bf16x8*)(lds + PG8_SA(b, h) + aoff + m * 2048 + k * 1024); } while (0)
#define PG8_LDB(dst, b, h) do { _Pragma("unroll") for (int n = 0; n < 2; ++n) _Pragma("unroll") for (int k = 0; k < 2; ++k) dst[n][k] = *(const PG8_LAS bf16x8*)(lds + PG8_SB(b, h) + boff + n * 2048 + k * 1024); } while (0)
#define PG8_MMA(ai, bj, At, Bt) do { __builtin_amdgcn_s_setprio(1); _Pragma("unroll") for (int m = 0; m < 4; ++m) _Pragma("unroll") for (int n = 0; n < 2; ++n) _Pragma("unroll") for (int k = 0; k < 2; ++k) \
        acc[ai][bj][m][n] = __builtin_amdgcn_mfma_f32_16x16x32_bf16(Bt[n][k], At[m][k], acc[ai][bj][m][n], 0, 0, 0); __builtin_amdgcn_s_setprio(0); } while (0)
#define PG8_WAIT_V(n) asm volatile("s_waitcnt vmcnt(" #n ")" ::: "memory")
#define PG8_WAIT_L(n) asm volatile("s_waitcnt lgkmcnt(" #n ")" ::: "memory")
#define PG8_BAR __builtin_amdgcn_s_barrier()
#define PG8_SCHED __builtin_amdgcn_sched_barrier(0)
    Unit cur, nxt; int ui = 0;
    if (!S.next(0, cur)) return;
    f32x4 acc[2][2][4][2];
#pragma unroll
    for (int a = 0; a < 2; ++a)
#pragma unroll
        for (int b = 0; b < 2; ++b)
#pragma unroll
            for (int m = 0; m < 4; ++m)
#pragma unroll
                for (int n = 0; n < 2; ++n) acc[a][b][m][n] = (f32x4){0.f, 0.f, 0.f, 0.f};
    bf16x8 At[4][2], B0[2][2], B1[2][2];
    const char* cA = (const char*)(cur.w ? g.A2 : g.A) + (size_t)cur.pm * tstep; const char* cB = (const char*)(cur.w ? g.Bt2 : g.Bt) + (size_t)cur.pn * tstep;
    S.a_ready(cur);
    if constexpr (SP2) {
        PG8_STAGE(PG8_SB(0, 0), cB, voffB); PG8_STAGE(PG8_SB(0, 1), cB + hstep, voffB); PG8_STAGE(PG8_SA(0, 0), cA, voffA); PG8_STAGE(PG8_SA(0, 1), cA + hstep, voffA);
        if (wr == 1) PG8_BAR;
        PG8_WAIT_V(2); PG8_BAR;
        PG8_STAGE(PG8_SB(1, 0), cB + kstep, voffB); PG8_STAGE(PG8_SA(1, 0), cA + kstep, voffA); PG8_STAGE(PG8_SB(1, 1), cB + hstep + kstep, voffB);
        PG8_WAIT_V(6); PG8_BAR;
    } else {
        PG8_STAGE(PG8_SB(0, 0), cB, voffB); PG8_STAGE(PG8_SA(0, 0), cA, voffA); PG8_STAGE(PG8_SB(0, 1), cB + hstep, voffB); PG8_STAGE(PG8_SA(0, 1), cA + hstep, voffA);
        if (wr == 1) PG8_BAR;
        PG8_WAIT_V(4); PG8_BAR;
        PG8_STAGE(PG8_SB(1, 0), cB + kstep, voffB); PG8_STAGE(PG8_SA(1, 0), cA + kstep, voffA); PG8_STAGE(PG8_SB(1, 1), cB + hstep + kstep, voffB);
        PG8_WAIT_V(6); PG8_BAR;
    }
    for (;;) {
        const bool has_next = S.next(ui + 1, nxt);
        const char* nA = has_next ? (const char*)(nxt.w ? g.A2 : g.A) + (size_t)nxt.pm * tstep : cA; const char* nB = has_next ? (const char*)(nxt.w ? g.Bt2 : g.Bt) + (size_t)nxt.pn * tstep : cB;
        for (int t = 0; t < nt; t += 2) {
            const bool last = (t == nt - 2);
            const char* a1 = cA + (size_t)(t + 1) * kstep;
            const char* a2 = last ? nA : cA + (size_t)(t + 2) * kstep; const char* b2 = last ? nB : cB + (size_t)(t + 2) * kstep;
            const char* a3 = a2 + kstep; const char* b3 = b2 + kstep;
            if (last && has_next) S.a_ready(nxt);
            if constexpr (SP2) {
            PG8_LDB(B0, 0, 0); PG8_LDB(B1, 0, 1); PG8_SCHED; PG8_LDA(At, 0, 0); PG8_STAGE(PG8_SA(1, 1), a1 + hstep, voffA);
            PG8_WAIT_V(8); PG8_WAIT_L(0); PG8_BAR; PG8_MMA(0, 0, At, B0); PG8_MMA(0, 1, At, B1); PG8_BAR; PG8_SCHED;
            PG8_LDA(At, 0, 1); PG8_STAGE(PG8_SB(0, 0), b2, voffB); PG8_STAGE(PG8_SB(0, 1), b2 + hstep, voffB); PG8_STAGE(PG8_SA(0, 0), a2, voffA);
            PG8_WAIT_V(8); PG8_WAIT_L(0); PG8_BAR; PG8_MMA(1, 0, At, B0); PG8_MMA(1, 1, At, B1); PG8_BAR; PG8_SCHED;
            PG8_LDB(B0, 1, 0); PG8_LDB(B1, 1, 1); PG8_SCHED; PG8_LDA(At, 1, 0); PG8_STAGE(PG8_SA(0, 1), a2 + hstep, voffA);
            PG8_WAIT_V(8); PG8_WAIT_L(0); PG8_BAR; PG8_MMA(0, 0, At, B0); PG8_MMA(0, 1, At, B1); PG8_BAR; PG8_SCHED;
            PG8_LDA(At, 1, 1); PG8_STAGE(PG8_SB(1, 0), b3, voffB); PG8_STAGE(PG8_SB(1, 1), b3 + hstep, voffB); PG8_STAGE(PG8_SA(1, 0), a3, voffA);
            PG8_WAIT_V(8); PG8_WAIT_L(0); PG8_BAR; PG8_MMA(1, 0, At, B0); PG8_MMA(1, 1, At, B1); PG8_BAR; PG8_SCHED;
            } else {
            PG8_LDB(B0, 0, 0); PG8_SCHED; PG8_LDA(At, 0, 0); PG8_STAGE(PG8_SA(1, 1), a1 + hstep, voffA);
            PG8_WAIT_L(8); PG8_BAR; PG8_WAIT_L(0); PG8_MMA(0, 0, At, B0); PG8_BAR; PG8_SCHED;
            PG8_LDB(B1, 0, 1); PG8_STAGE(PG8_SB(0, 0), b2, voffB);
            PG8_BAR; PG8_WAIT_L(0); PG8_MMA(0, 1, At, B1); PG8_BAR;
            PG8_LDA(At, 0, 1); PG8_STAGE(PG8_SA(0, 0), a2, voffA);
            PG8_BAR; PG8_WAIT_L(0); PG8_MMA(1, 0, At, B0); PG8_BAR; PG8_SCHED;
            PG8_STAGE(PG8_SB(0, 1), b2 + hstep, voffB);
            PG8_WAIT_V(6); PG8_BAR; PG8_MMA(1, 1, At, B1); PG8_BAR;
            PG8_LDB(B0, 1, 0); PG8_SCHED; PG8_LDA(At, 1, 0); PG8_STAGE(PG8_SA(0, 1), a2 + hstep, voffA);
            PG8_WAIT_L(8); PG8_BAR; PG8_WAIT_L(0); PG8_MMA(0, 0, At, B0); PG8_BAR; PG8_SCHED;
            PG8_LDB(B1, 1, 1); PG8_STAGE(PG8_SB(1, 0), b3, voffB);
            PG8_BAR; PG8_WAIT_L(0); PG8_MMA(0, 1, At, B1); PG8_BAR;
            PG8_LDA(At, 1, 1); PG8_STAGE(PG8_SA(1, 0), a3, voffA);
            PG8_BAR; PG8_WAIT_L(0); PG8_MMA(1, 0, At, B0); PG8_BAR; PG8_SCHED;
            PG8_STAGE(PG8_SB(1, 1), b3 + hstep, voffB);
            PG8_WAIT_V(6); PG8_BAR; PG8_MMA(1, 1, At, B1); PG8_BAR;
            }
        }
        if constexpr (ALIGN_EPI) { if (wr == 0) PG8_BAR; }
        if constexpr (!Epi::AFTER_DRAIN) { E(acc, cur, wr, wc, fr, fq); S.done(cur); }
        if (!has_next) break;
        if (!(is_chain<Epi>::value && cur.w == 0)) {
#pragma unroll
        for (int a = 0; a < 2; ++a)
#pragma unroll
            for (int b = 0; b < 2; ++b)
#pragma unroll
                for (int m = 0; m < 4; ++m)
#pragma unroll
                    for (int n = 0; n < 2; ++n) acc[a][b][m][n] = (f32x4){0.f, 0.f, 0.f, 0.f};
        }
        cur = nxt; cA = nA; cB = nB; ++ui;
        if constexpr (ALIGN_EPI) { if (wr == 1) PG8_BAR; }
    }
    PG8_WAIT_V(0);
    if constexpr (!ALIGN_EPI) { if (wr == 0) PG8_BAR; }
    PG8_BAR;
    if constexpr (Epi::AFTER_DRAIN) { E.fused(acc, cur, wr, wc, fr, fq, lds, wid, lane); S.done(cur); }
#undef PG8_SA
#undef PG8_SB
#undef PG8_STAGE
#undef PG8_LDA
#undef PG8_LDB
#undef PG8_MMA
#undef PG8_WAIT_V
#undef PG8_WAIT_L
#undef PG8_BAR
#undef PG8_SCHED
}
}

namespace ep {
using pg8::f32x4; using pg8::Unit; using pg8::cvt_pk_bf16;
typedef unsigned u32x2v __attribute__((ext_vector_type(2)));
#define EP_LAS __attribute__((address_space(3)))
__device__ __forceinline__ u32x2v pack4(f32x4 v) { u32x2v w; w.x = cvt_pk_bf16(v[0], v[1]); w.y = cvt_pk_bf16(v[2], v[3]); return w; }
__device__ __forceinline__ f32x4 unpack4(u32x2v w) { f32x4 v; v[0] = __uint_as_float(w.x << 16); v[1] = __uint_as_float(w.x & 0xffff0000u); v[2] = __uint_as_float(w.y << 16); v[3] = __uint_as_float(w.y & 0xffff0000u); return v; }
__device__ __forceinline__ float fsilu(float v) { return v * __builtin_amdgcn_rcpf(1.f + __builtin_amdgcn_exp2f(-v * LOG2E)); }
__device__ __forceinline__ float fsigm(float v) { return __builtin_amdgcn_rcpf(1.f + __builtin_amdgcn_exp2f(-v * LOG2E)); }
__device__ __forceinline__ f32x4 silu4(f32x4 v) { f32x4 r; r[0] = fsilu(v[0]); r[1] = fsilu(v[1]); r[2] = fsilu(v[2]); r[3] = fsilu(v[3]); return r; }
__device__ __forceinline__ f32x4 sigm4(f32x4 v) { f32x4 r; r[0] = fsigm(v[0]); r[1] = fsigm(v[1]); r[2] = fsigm(v[2]); r[3] = fsigm(v[3]); return r; }
#define EP_BAR() do { asm volatile("s_waitcnt lgkmcnt(0)" ::: "memory"); __builtin_amdgcn_s_barrier(); asm volatile("" ::: "memory"); } while (0)

struct EpiP1 {
    static constexpr bool PERM = true, AFTER_DRAIN = false;
    unsigned char* ws; const float* qn; const float* kn; EP_LAS float* xs;
    __device__ __forceinline__ void operator()(const f32x4 (&acc)[2][2][4][2], const Unit& u, int wr, int wc, int fr, int fq) const {
        const int pn = u.pn, rl = wr * 64 + fr, rbase = u.pm * 256 + rl, cl = wc * 32 + 4 * fq;
        if (pn < 8 || pn >= 16) {
            if (pn == 20) {
                float* LR = (float*)(ws + WS_LR);
                if (wc == 0) {
#pragma unroll
                    for (int ai = 0; ai < 2; ++ai)
#pragma unroll
                        for (int m = 0; m < 4; ++m)
#pragma unroll
                            for (int n = 0; n < 2; ++n) *(f32x4*)(LR + (size_t)(rbase + 128 * ai + 16 * m) * 32 + 8 * fq + 4 * n) = acc[ai][0][m][n];
                }
                return;
            }
            bf16_t* dst; int ld, c0; float sc = 1.f;
            if (pn < 2) { dst = (bf16_t*)(ws + WS_GQ); ld = 512; c0 = 256 * pn; sc = 0.08838834764831845f; }
            else if (pn < 4) { dst = (bf16_t*)(ws + WS_GK); ld = 512; c0 = 256 * (pn - 2); }
            else if (pn < 8) { dst = (bf16_t*)(ws + WS_GV); ld = 1024; c0 = 256 * (pn - 4); }
            else { dst = (bf16_t*)(ws + WS_DV); ld = 1024; c0 = 256 * (pn - 16); }
#pragma unroll
            for (int ai = 0; ai < 2; ++ai)
#pragma unroll
                for (int m = 0; m < 4; ++m) { bf16_t* rp = dst + (size_t)(rbase + 128 * ai + 16 * m) * ld + c0 + wc * 32 + 8 * fq;
#pragma unroll
                    for (int bj = 0; bj < 2; ++bj) { const u32x2v lo = pack4(acc[ai][bj][m][0] * sc), hi2 = pack4(acc[ai][bj][m][1] * sc);
                        *(u32x4*)(rp + 128 * bj) = (u32x4){lo.x, lo.y, hi2.x, hi2.y}; } }
            return;
        }
        const bool isq = pn < 12, lat = u.pm < 128;
        const int c0 = 256 * (pn - (isq ? 8 : 12));
        float ssq[2][4][2];
#pragma unroll
        for (int ai = 0; ai < 2; ++ai)
#pragma unroll
            for (int m = 0; m < 4; ++m)
#pragma unroll
                for (int bj = 0; bj < 2; ++bj) {
                    const f32x4 a = acc[ai][bj][m][0], b = acc[ai][bj][m][1];
                    float s = (a[0] * a[0] + a[1] * a[1]) + (a[2] * a[2] + a[3] * a[3]) + (b[0] * b[0] + b[1] * b[1]) + (b[2] * b[2] + b[3] * b[3]);
                    s += __shfl_xor(s, 16); s += __shfl_xor(s, 32);
                    ssq[ai][m][bj] = s;
                    if (fq == 0) xs[(bj * 4 + wc) * 256 + 128 * ai + 16 * m + rl] = s;
                }
        EP_BAR();
        const float* gain = isq ? qn : kn;
        const int d0 = 32 * (wc & 1) + 4 * fq;
        const f32x4 g0 = *(const f32x4*)(gain + d0), g1 = *(const f32x4*)(gain + d0 + 16);
        const float osc = isq ? QC2 : 1.f;
        const float* TABC = (const float*)(ws + WS_TAB); const float* TABS = TABC + 2048;
        bf16_t* dst = isq ? (bf16_t*)(ws + WS_DQ) : (bf16_t*)(ws + WS_DK);
        if (isq && !lat) return;
#pragma unroll
        for (int ai = 0; ai < 2; ++ai) {
            f32x4 csv[4], snv[4];
#pragma unroll
            for (int m = 0; m < 4; ++m) { csv[m] = (f32x4){1.f, 1.f, 1.f, 1.f}; snv[m] = (f32x4){0.f, 0.f, 0.f, 0.f};
                if (lat) { const int t = (rbase + 128 * ai + 16 * m) & (SEQ - 1), pos = (wc & 1) ? (t & 63) : (t >> 6); csv[m] = *(const f32x4*)(TABC + pos * 16 + 4 * fq); snv[m] = *(const f32x4*)(TABS + pos * 16 + 4 * fq); } }
            asm volatile("" ::: "memory");
#pragma unroll
            for (int m = 0; m < 4; ++m) {
                const int row = rbase + 128 * ai + 16 * m;
                const f32x4 cs = csv[m], sn = snv[m];
#pragma unroll
                for (int bj = 0; bj < 2; ++bj) {
                    const float tot = ssq[ai][m][bj] + xs[(bj * 4 + (wc ^ 1)) * 256 + 128 * ai + 16 * m + rl];
                    const float rstd = rsqrtf(tot * (1.f / 64.f) + EPS) * osc;
                    const f32x4 x0 = acc[ai][bj][m][0] * rstd * g0, x1 = acc[ai][bj][m][1] * rstd * g1;
                    const f32x4 o0 = x0 * cs - x1 * sn, o1 = x1 * cs + x0 * sn;
                    bf16_t* rp = dst + (size_t)row * DM + c0 + 128 * bj + cl;
                    *(u32x2v*)(rp) = pack4(o0); *(u32x2v*)(rp + 16) = pack4(o1);
                }
            }
        }
    }
};
struct EpiP25 {
    static constexpr bool PERM = true, AFTER_DRAIN = false;
    unsigned char* ws; const bf16_t* OF; const float* gla_norm; EP_LAS float* xs;
    __device__ __forceinline__ void operator()(const f32x4 (&acc)[2][2][4][2], const Unit& u, int wr, int wc, int fr, int fq) const {
        int fr_ = fr, fq_ = fq; asm volatile("" : "+v"(fr_), "+v"(fq_));
        const int pn = u.pn, rl = wr * 64 + fr_, rbase = u.pm * 256 + rl, cl = wc * 32 + 8 * fq_;
        if (pn >= 4) {
            bf16_t* dst = pn < 8 ? (bf16_t*)(ws + WS_DQ) : pn < 12 ? (bf16_t*)(ws + WS_SG) : (bf16_t*)(ws + WS_SD);
            const int c0 = 256 * (pn & 3);
            if (pn >= 8) {
#pragma unroll
                for (int ai = 0; ai < 2; ++ai)
#pragma unroll
                    for (int m = 0; m < 4; ++m) { bf16_t* rp = dst + (size_t)(rbase + 128 * ai + 16 * m) * DM + c0 + cl;
#pragma unroll
                        for (int bj = 0; bj < 2; ++bj) { const u32x2v lo = pack4(acc[ai][bj][m][0]), hi2 = pack4(acc[ai][bj][m][1]);
                            *(u32x4*)(rp + 128 * bj) = (u32x4){lo.x, lo.y, hi2.x, hi2.y}; } }
            } else {
#pragma unroll
                for (int aim2 = 0; aim2 < 4; ++aim2) {
                    u32x4 oldv[2][2];
#pragma unroll
                    for (int k = 0; k < 2; ++k)
#pragma unroll
                        for (int bj = 0; bj < 2; ++bj) { const int aim = 2 * aim2 + k; oldv[k][bj] = *(const u32x4*)(dst + (size_t)(rbase + 128 * (aim >> 2) + 16 * (aim & 3)) * DM + c0 + cl + 128 * bj); }
                    asm volatile("" ::: "memory");
#pragma unroll
                    for (int k = 0; k < 2; ++k) { const int aim = 2 * aim2 + k, ai = aim >> 2, m = aim & 3; bf16_t* rp = dst + (size_t)(rbase + 128 * ai + 16 * m) * DM + c0 + cl;
#pragma unroll
                        for (int bj = 0; bj < 2; ++bj) { const u32x4 old = oldv[k][bj];
                            const u32x2v lo = pack4(unpack4((u32x2v){old.x, old.y}) * silu4(acc[ai][bj][m][0])), hi2 = pack4(unpack4((u32x2v){old.z, old.w}) * silu4(acc[ai][bj][m][1]));
                            *(u32x4*)(rp + 128 * bj) = (u32x4){lo.x, lo.y, hi2.x, hi2.y}; } }
                }
            }
            return;
        }
        const bf16_t* OB = OF + (size_t)NLAT * DM;
        const int c0 = 256 * pn;
        float ssq[2][4];
#pragma unroll
        for (int aim2 = 0; aim2 < 4; ++aim2) {
            u32x4 fv[2][2], gv[2][2];
#pragma unroll
            for (int k = 0; k < 2; ++k)
#pragma unroll
                for (int bj = 0; bj < 2; ++bj) { const int aim = 2 * aim2 + k; const size_t ro = (size_t)(rbase + 128 * (aim >> 2) + 16 * (aim & 3)) * DM + c0 + cl + 128 * bj; fv[k][bj] = *(const u32x4*)(OF + ro); gv[k][bj] = *(const u32x4*)(OB + ro); }
#pragma unroll
            for (int k = 0; k < 2; ++k) { const int aim = 2 * aim2 + k, ai = aim >> 2, m = aim & 3; float s = 0.f;
#pragma unroll
                for (int bj = 0; bj < 2; ++bj) { const u32x4 f = fv[k][bj], g = gv[k][bj];
                    const f32x4 o0 = unpack4((u32x2v){f.x, f.y}) + unpack4((u32x2v){g.x, g.y}), o1 = unpack4((u32x2v){f.z, f.w}) + unpack4((u32x2v){g.z, g.w});
                    s += (o0[0] * o0[0] + o0[1] * o0[1]) + (o0[2] * o0[2] + o0[3] * o0[3]) + (o1[0] * o1[0] + o1[1] * o1[1]) + (o1[2] * o1[2] + o1[3] * o1[3]); }
                s += __shfl_xor(s, 16); s += __shfl_xor(s, 32);
                ssq[ai][m] = s;
                if (fq_ == 0) xs[wc * 256 + 128 * ai + 16 * m + rl] = s;
            }
        }
        EP_BAR();
        bf16_t* A = (bf16_t*)(ws + WS_A);
        f32x4 gn[2][2];
#pragma unroll
        for (int bj = 0; bj < 2; ++bj)
#pragma unroll
            for (int n = 0; n < 2; ++n) gn[bj][n] = *(const f32x4*)(gla_norm + 128 * bj + cl + 4 * n);
        u32x4 nfa, nga, nfb, ngb;
        { const size_t ro = (size_t)rbase * DM + c0 + cl; nfa = *(const u32x4*)(OF + ro); nga = *(const u32x4*)(OB + ro); nfb = *(const u32x4*)(OF + ro + 128); ngb = *(const u32x4*)(OB + ro + 128); }
#pragma unroll
        for (int aim = 0; aim < 8; ++aim) { const int ai = aim >> 2, m = aim & 3;
            const u32x4 fa = nfa, ga = nga, fb = nfb, gb = ngb;
            if (aim < 7) { const size_t rn = (size_t)(rbase + 128 * ((aim + 1) >> 2) + 16 * ((aim + 1) & 3)) * DM + c0 + cl; nfa = *(const u32x4*)(OF + rn); nga = *(const u32x4*)(OB + rn); nfb = *(const u32x4*)(OF + rn + 128); ngb = *(const u32x4*)(OB + rn + 128); }
            asm volatile("" ::: "memory");
            const int rr = 128 * ai + 16 * m + rl;
            const float tot = (xs[rr] + xs[256 + rr]) + (xs[512 + rr] + xs[768 + rr]);
            const float rstd = rsqrtf(tot * (1.f / 256.f) + EPS);
            const size_t ro = (size_t)(rbase + 128 * ai + 16 * m) * DM + c0 + cl;
#pragma unroll
            for (int bj = 0; bj < 2; ++bj) { const u32x4 f = bj ? fb : fa, g = bj ? gb : ga;
                const f32x4 o0 = unpack4((u32x2v){f.x, f.y}) + unpack4((u32x2v){g.x, g.y}), o1 = unpack4((u32x2v){f.z, f.w}) + unpack4((u32x2v){g.z, g.w});
                const u32x2v lo = pack4(o0 * rstd * gn[bj][0] * silu4(acc[ai][bj][m][0])), hi2 = pack4(o1 * rstd * gn[bj][1] * silu4(acc[ai][bj][m][1]));
                *(u32x4*)(A + ro + 128 * bj) = (u32x4){lo.x, lo.y, hi2.x, hi2.y}; }
        }
    }
};
template <int PASS> struct EpiY {
    static constexpr bool PERM = true, AFTER_DRAIN = false;
    unsigned char* ws;
    __device__ __forceinline__ void operator()(const f32x4 (&acc)[2][2][4][2], const Unit& u, int wr, int wc, int fr, int fq) const {
        const int rbase = u.pm * 256 + wr * 64 + fr, cl = 256 * u.pn + wc * 32 + 8 * fq;
        bf16_t* Y = (bf16_t*)(ws + WS_Y); const bf16_t* G = (const bf16_t*)(ws + (PASS == 0 ? WS_SG : WS_SD));
#pragma unroll
        for (int aim = 0; aim < (PASS == 1 ? 4 : 2); ++aim) { const int ai = PASS == 1 ? aim >> 1 : aim, m0 = PASS == 1 ? 2 * (aim & 1) : 0, m1 = PASS == 1 ? m0 + 2 : 4;
            u32x4 gtv[4][2], yv[4][2];
#pragma unroll
            for (int m = m0; m < m1; ++m)
#pragma unroll
                for (int bj = 0; bj < 2; ++bj) { const size_t o = (size_t)(rbase + 128 * ai + 16 * m) * DM + cl + 128 * bj; gtv[m][bj] = *(const u32x4*)(G + o); if (PASS == 1) yv[m][bj] = *(const u32x4*)(Y + o); }
            asm volatile("" ::: "memory");
#pragma unroll
            for (int m = m0; m < m1; ++m) { const size_t ro = (size_t)(rbase + 128 * ai + 16 * m) * DM + cl;
#pragma unroll
                for (int bj = 0; bj < 2; ++bj) { const size_t o = ro + 128 * bj;
                    const u32x4 gt = gtv[m][bj];
                    f32x4 v0 = sigm4(unpack4((u32x2v){gt.x, gt.y})) * acc[ai][bj][m][0], v1 = sigm4(unpack4((u32x2v){gt.z, gt.w})) * acc[ai][bj][m][1];
                    if (PASS == 1) { const u32x4 y = yv[m][bj]; v0 = v0 + unpack4((u32x2v){y.x, y.y}); v1 = v1 + unpack4((u32x2v){y.z, y.w}); }
                    const u32x2v lo = pack4(v0), hi2 = pack4(v1);
                    *(u32x4*)(Y + o) = (u32x4){lo.x, lo.y, hi2.x, hi2.y}; } }
        }
    }
};
struct EpiY2 {
    static constexpr bool PERM = true, AFTER_DRAIN = false, CHAIN = true;
    unsigned char* ws;
    static __device__ __forceinline__ f32x4 ope4(f32x4 v) { f32x4 r;
#pragma unroll
        for (int e = 0; e < 4; ++e) r[e] = 1.f + __builtin_amdgcn_exp2f(fminf(v[e] * -LOG2E, 60.f * LOG2E));
        return r; }
    static __device__ __forceinline__ f32x4 rcp4(f32x4 v) { f32x4 r; r[0] = __builtin_amdgcn_rcpf(v[0]); r[1] = __builtin_amdgcn_rcpf(v[1]); r[2] = __builtin_amdgcn_rcpf(v[2]); r[3] = __builtin_amdgcn_rcpf(v[3]); return r; }
    __device__ __forceinline__ void operator()(f32x4 (&acc)[2][2][4][2], const Unit& u, int wr, int wc, int fr, int fq) const {
        const int rbase = u.pm * 256 + wr * 64 + fr, cl = 256 * u.pn + wc * 32 + 8 * fq;
        bf16_t* Y = (bf16_t*)(ws + WS_Y); const bf16_t* GS = (const bf16_t*)(ws + WS_SG); const bf16_t* GD = (const bf16_t*)(ws + WS_SD); bf16_t* GDW = (bf16_t*)(ws + WS_SD);
        if (u.w == 0) {
#pragma unroll
            for (int aim = 0; aim < 4; ++aim) { const int ai = aim >> 1, m0 = 2 * (aim & 1);
                u32x4 gsv[2][2], gdv[2][2];
#pragma unroll
                for (int mm = 0; mm < 2; ++mm)
#pragma unroll
                    for (int bj = 0; bj < 2; ++bj) { const size_t o = (size_t)(rbase + 128 * ai + 16 * (m0 + mm)) * DM + cl + 128 * bj; gsv[mm][bj] = *(const u32x4*)(GS + o); gdv[mm][bj] = *(const u32x4*)(GD + o); }
#pragma unroll
                for (int mm = 0; mm < 2; ++mm)
#pragma unroll
                    for (int bj = 0; bj < 2; ++bj) { const u32x4 gs = gsv[mm][bj], gd = gdv[mm][bj];
                        const f32x4 e0 = ope4(unpack4((u32x2v){gd.x, gd.y})), e1 = ope4(unpack4((u32x2v){gd.z, gd.w}));
                        acc[ai][bj][m0 + mm][0] = acc[ai][bj][m0 + mm][0] * (sigm4(unpack4((u32x2v){gs.x, gs.y})) * e0);
                        acc[ai][bj][m0 + mm][1] = acc[ai][bj][m0 + mm][1] * (sigm4(unpack4((u32x2v){gs.z, gs.w})) * e1);
                        const u32x2v p0 = pack4(e0), p1 = pack4(e1);
                        *(u32x4*)(GDW + (size_t)(rbase + 128 * ai + 16 * (m0 + mm)) * DM + cl + 128 * bj) = (u32x4){p0.x, p0.y, p1.x, p1.y}; }
            }
        } else {
#pragma unroll
            for (int ai = 0; ai < 2; ++ai) {
                u32x4 gdv[4][2];
#pragma unroll
                for (int m = 0; m < 4; ++m)
#pragma unroll
                    for (int bj = 0; bj < 2; ++bj) gdv[m][bj] = *(const u32x4*)(GD + (size_t)(rbase + 128 * ai + 16 * m) * DM + cl + 128 * bj);
                asm volatile("" ::: "memory");
#pragma unroll
                for (int m = 0; m < 4; ++m)
#pragma unroll
                    for (int bj = 0; bj < 2; ++bj) { const size_t o = (size_t)(rbase + 128 * ai + 16 * m) * DM + cl + 128 * bj; const u32x4 gd = gdv[m][bj];
                        const u32x2v lo = pack4(acc[ai][bj][m][0] * rcp4(unpack4((u32x2v){gd.x, gd.y}))), hi2 = pack4(acc[ai][bj][m][1] * rcp4(unpack4((u32x2v){gd.z, gd.w})));
                        *(u32x4*)(Y + o) = (u32x4){lo.x, lo.y, hi2.x, hi2.y}; }
            }
        }
    }
};
struct EpiOut {
    static constexpr bool PERM = true, AFTER_DRAIN = false;
    const float* x; float* out; const float* MOD;
    __device__ __forceinline__ void operator()(const f32x4 (&acc)[2][2][4][2], const Unit& u, int wr, int wc, int fr, int fq) const {
        const int rbase = u.pm * 256 + wr * 64 + fr, cl = 256 * u.pn + wc * 32 + 8 * fq, b = u.pm >> 5;
        f32x4 g[2][2];
#pragma unroll
        for (int bj = 0; bj < 2; ++bj)
#pragma unroll
            for (int n = 0; n < 2; ++n) g[bj][n] = *(const f32x4*)(MOD + b * 3072 + 2048 + cl + 128 * bj + 4 * n);
        const float* __restrict__ xr_ = x; float* __restrict__ or_ = out;
#pragma unroll
        for (int ai = 0; ai < 2; ++ai) {
            f32x4 xv[4][2][2];
#pragma unroll
            for (int m = 0; m < 4; ++m)
#pragma unroll
                for (int bj = 0; bj < 2; ++bj)
#pragma unroll
                    for (int n = 0; n < 2; ++n) xv[m][bj][n] = *(const f32x4*)(xr_ + (size_t)(rbase + 128 * ai + 16 * m) * DM + cl + 128 * bj + 4 * n);
            asm volatile("" ::: "memory");
#pragma unroll
            for (int m = 0; m < 4; ++m)
#pragma unroll
                for (int bj = 0; bj < 2; ++bj)
#pragma unroll
                    for (int n = 0; n < 2; ++n) *(f32x4*)(or_ + (size_t)(rbase + 128 * ai + 16 * m) * DM + cl + 128 * bj + 4 * n) = xv[m][bj][n] + g[bj][n] * acc[ai][bj][m][n];
        }
    }
};
template <class E_> struct Twice { static constexpr bool PERM = E_::PERM, AFTER_DRAIN = false; E_ e;
    __device__ __forceinline__ void operator()(const f32x4 (&acc)[2][2][4][2], const Unit& u, int wr, int wc, int fr, int fq) const { e(acc, u, wr, wc, fr, fq); EP_BAR(); e(acc, u, wr, wc, fr, fq); } };
}

__device__ __forceinline__ void transpose_item(const float* W, int ldw, bf16_t* WT, int item, int nblk, EP_LAS float* scr, int lane, int mode) {
    const int kb = item / nblk, nb = item % nblk, k0 = 64 * kb, n0 = 32 * nb;
    {
        float tw_[32];
        const float* wp_ = W + (size_t)(k0 + (lane >> 5)) * ldw + n0 + (lane & 31);
#pragma unroll
        for (int i = 0; i < 32; ++i) tw_[i] = wp_[(size_t)(2 * i) * ldw];
#pragma unroll
        for (int i = 0; i < 32; ++i) scr[(2 * i + (lane >> 5)) * 33 + (lane & 31)] = tw_[i];
    }
    asm volatile("s_waitcnt lgkmcnt(0)" ::: "memory");
    if (mode == 3) {
        const int kbase = (k0 & ~127) + 2 * ((k0 >> 6) & 1);
#pragma unroll 4
        for (int i = 0; i < 16; ++i) { const int idx = lane + 64 * i, n = idx & 31, j = idx >> 5;
            *(unsigned*)(WT + (size_t)(n0 + n) * DM + kbase + 4 * j) = pk2(scr[j * 33 + n], scr[(32 + j) * 33 + n]); }
    } else {
        const int c = lane & 7;
#pragma unroll
        for (int j = 0; j < 4; ++j) { const int n = (lane >> 3) + 8 * j; const EP_LAS float* sp = scr + (8 * c) * 33 + n;
            u32x4 o; o.x = pk2(sp[0 * 33], sp[1 * 33]); o.y = pk2(sp[2 * 33], sp[3 * 33]); o.z = pk2(sp[4 * 33], sp[5 * 33]); o.w = pk2(sp[6 * 33], sp[7 * 33]);
            int nrow = n0 + n;
            if (mode == 1) nrow = n0 + (8 * ((n >> 2) & 3) + 4 * (n >> 4) + (n & 3));
            if (mode == 2) nrow = (n0 & ~127) + 4 * n + ((n0 >> 5) & 3);
            *(u32x4*)(WT + (size_t)nrow * DM + k0 + 8 * c) = o; }
    }
    asm volatile("s_waitcnt lgkmcnt(0)" ::: "memory");
}
constexpr size_t WS_WINT2 = 12 * MiB, WS_WBRG = 21 * MiB, WS_WBRD = 23 * MiB;
constexpr int N1 = 5376, N2 = 4096;
template <bool LATE>
__device__ __forceinline__ void p0_weights(const Params& p, unsigned char* smem, int wv) {
    int tid = GET_TID(wv); asm volatile("" : "+v"(tid)); const int lane = tid & 63, wave = tid >> 6;
    const int gw = blockIdx.x * 8 + wave, NGW = gridDim.x * 8;
    EP_LAS float* scr = (EP_LAS float*)(smem) + wave * (64 * 33);
    bf16_t* W1 = (bf16_t*)(p.ws + WS_WINT); bf16_t* W2 = (bf16_t*)(p.ws + WS_WINT2);
    unsigned* wctr = (unsigned*)(p.ws + WS_CTR) + 128;
    LAS unsigned* wslot = (LAS unsigned*)(smem + LDS_BYTES - 56);
    for (int fit = LATE ? 0 : gw; LATE || fit < 2576; fit += NGW) {
        if (LATE) {
            __syncthreads();
            if (tid == 0) *wslot = atomicAdd(wctr, 8u);
            __syncthreads();
            const unsigned t = *wslot;
            if (t >= 3584u) break;
            fit = 2576 + (int)t + wave;
        }
        int seg, it;
        if (fit < 512) { seg = fit >> 8; it = fit & 255; }
        else if (fit < 2560) { seg = 2 + ((fit - 512) >> 9); it = (fit - 512) & 511; }
        else if (fit < 2576) { seg = 6; it = fit - 2560; }
        else { seg = 7 + ((fit - 2576) >> 9); it = (fit - 2576) & 511; }
        const float* src; int ldw, width; bf16_t* dst;
        switch (seg) {
            case 0: src = p.w_in + C_GQ; ldw = INW; width = 512; dst = W1; break;
            case 1: src = p.w_in + C_GK; ldw = INW; width = 512; dst = W1 + (size_t)512 * DM; break;
            case 2: src = p.w_in + C_GV; ldw = INW; width = 1024; dst = W1 + (size_t)1024 * DM; break;
            case 3: src = p.w_in + C_DQ; ldw = INW; width = 1024; dst = W1 + (size_t)2048 * DM; break;
            case 4: src = p.w_in + C_DK; ldw = INW; width = 1024; dst = W1 + (size_t)3072 * DM; break;
            case 5: src = p.w_in + C_DV; ldw = INW; width = 1024; dst = W1 + (size_t)4096 * DM; break;
            case 6: src = p.w_in + C_LR; ldw = INW; width = 32; dst = W1 + (size_t)5120 * DM; break;
            case 7: src = p.w_in + C_GG; ldw = INW; width = 1024; dst = W2; break;
            case 8: src = p.w_in + C_DG; ldw = INW; width = 1024; dst = W2 + (size_t)1024 * DM; break;
            case 9: src = p.w_in + C_MG; ldw = INW; width = 1024; dst = W2 + (size_t)2048 * DM; break;
            case 10: src = p.w_in + C_MD; ldw = INW; width = 1024; dst = W2 + (size_t)3072 * DM; break;
            case 11: src = p.w_brg; ldw = DM; width = 1024; dst = (bf16_t*)(p.ws + WS_WBRG); break;
            case 12: src = p.w_brd; ldw = DM; width = 1024; dst = (bf16_t*)(p.ws + WS_WBRD); break;
            default: src = p.w_out; ldw = DM; width = 1024; dst = (bf16_t*)(p.ws + WS_WOUTT); break;
        }
        const int nblk = width / 32;
        transpose_item(src, ldw, dst, it, nblk, scr, lane, (seg == 3 || seg == 4) ? 1 : seg == 8 ? 2 : seg == 12 ? 3 : 0);
    }
}

__global__ void __launch_bounds__(NTHREADS, 2) fwd_kernel(Params p) {
    extern __shared__ __attribute__((aligned(16))) unsigned char smem[];
    cg::grid_group grid = cg::this_grid();
    const int wv = __builtin_amdgcn_readfirstlane((int)threadIdx.x >> 6);
    const int lo = p.ph_lo, hi = p.ph_hi;
    if (threadIdx.x < 16) ((LAS unsigned*)(smem + LDS_BYTES - 128))[threadIdx.x] = 0u;
    __syncthreads();
    unsigned xrank; XcdBarrier bar = xcd_barrier_post((unsigned*)(p.ws + WS_BAR), (volatile LAS unsigned*)(smem + LDS_BYTES - 128), threadIdx.x == 0, xrank);
#define IN(k) (lo <= (k) && (k) < hi)
    if (lo < 0) grid.sync();
#define SEAM(k) do { if (IN(k) && IN((k) + 1)) xcd_barrier(bar, wv == 0 && lane_id() == 0); } while (0)
#ifndef SK0
    if (IN(0)) { p0a_naive(p, wv, smem); p0_weights<false>(p, smem, wv); }
#endif
    SEAM(0);
    {
        LAS unsigned* vw = (LAS unsigned*)(smem + LDS_BYTES - 48);
        if (threadIdx.x == 0) {
            const unsigned G8 = gridDim.x / 8u; bool okx = (gridDim.x % 8u) == 0u;
            for (unsigned j = 0; j < 16u; ++j) { const unsigned cj = xb_ld(&bar.bar[XB_XCNT(j)]); okx = okx && (cj == (j < 8u ? G8 : 0u)); }
            *vw = okx ? (xrank * 8u + (bar.x & 7u)) : (unsigned)blockIdx.x;
        }
        __syncthreads();
    }
#define VCU() ((int)__builtin_amdgcn_readfirstlane(*(LAS unsigned*)(smem + LDS_BYTES - 48)))
#ifndef SK1
    if (IN(1)) { p0b_norm(p, wv);
#if PROBE == 5
        p0b_norm(p, wv);
#endif
    }
#endif
    SEAM(1);
#if PROBE == 10
    if (IN(2)) {
        pg8::Gemm g{(const bf16_t*)(p.ws + WS_Y), (const bf16_t*)(p.ws + WS_WOUTT), NLAT, DM, DM, nullptr, nullptr}; pg8::StaticOrder S; S.init(NLAT, DM, (int)gridDim.x, VCU());
        ep::EpiOut E{p.x, p.out, (const float*)(p.ws + WS_MOD)};
        pg8::gemm_phase<ep::EpiOut, pg8::StaticOrder, true, true>((PG8_LAS unsigned char*)smem, g, S, E, wv);
        xcd_barrier(bar, wv == 0 && lane_id() == 0);
    }
#endif
#ifndef SK2
    if (IN(2)) {
        pg8::Gemm g{(const bf16_t*)(p.ws + WS_H), (const bf16_t*)(p.ws + WS_WINT), NROW, N1, DM, nullptr, nullptr}; pg8::StaticOrder S; S.init(NROW, N1, (int)gridDim.x, VCU());
        ep::EpiP1 E{p.ws, p.qn, p.kn, (EP_LAS float*)(smem + 131072)};
#if PROBE == 7
        ep::Twice<ep::EpiP1> E2{E};
        pg8::gemm_phase<ep::Twice<ep::EpiP1>, pg8::StaticOrder, true, true>((PG8_LAS unsigned char*)smem, g, S, E2, wv);
#else
        pg8::gemm_phase<ep::EpiP1, pg8::StaticOrder, true, true>((PG8_LAS unsigned char*)smem, g, S, E, wv);
#endif
#if PROBE == 2
        pg8::gemm_phase<ep::EpiP1, pg8::StaticOrder, true, true>((PG8_LAS unsigned char*)smem, g, S, E, wv);
#endif
    }
#endif
    SEAM(2);
#ifndef SK3A
    if (IN(3)) { p2a_logdecay(p, smem, wv); xcd_barrier(bar, wv == 0 && lane_id() == 0, blockIdx.x < 32); p2_mixed(p, smem, wv); }
#endif
    SEAM(3);
#ifndef SK5
    if (IN(4)) {
        pg8::Gemm g{(const bf16_t*)(p.ws + WS_H), (const bf16_t*)(p.ws + WS_WINT2), NLAT, N2, DM, nullptr, nullptr}; pg8::MixOrder S; S.init(NLAT, N2, (int)gridDim.x, VCU());
        ep::EpiP25 E{p.ws, (const bf16_t*)p.out, p.gla_norm, (EP_LAS float*)(smem + 131072)};
        pg8::gemm_phase<ep::EpiP25, pg8::MixOrder, true, true>((PG8_LAS unsigned char*)smem, g, S, E, wv);
    }
#endif
    SEAM(4);
#ifndef SK6
    if (IN(5)) {
        pg8::StaticOrder S; S.init(NLAT, DM, (int)gridDim.x, VCU());
#if PROBE == 8
        for (int rep_ = 0; rep_ < 2; ++rep_) {
        { pg8::Gemm g{(const bf16_t*)(p.ws + WS_A), (const bf16_t*)(p.ws + WS_WBRG), NLAT, DM, DM, nullptr, nullptr}; ep::EpiY<0> E{p.ws};
          pg8::gemm_phase<ep::EpiY<0>, pg8::StaticOrder, true, true>((PG8_LAS unsigned char*)smem, g, S, E, wv); }
        { pg8::Gemm g{(const bf16_t*)(p.ws + WS_DQ), (const bf16_t*)(p.ws + WS_WBRD), NLAT, DM, DM, nullptr, nullptr}; ep::EpiY<1> E{p.ws};
          pg8::gemm_phase<ep::EpiY<1>, pg8::StaticOrder, true, true>((PG8_LAS unsigned char*)smem, g, S, E, wv); }
        }
#else
        { pg8::Gemm g{(const bf16_t*)(p.ws + WS_A), (const bf16_t*)(p.ws + WS_WBRG), NLAT, DM, DM, (const bf16_t*)(p.ws + WS_DQ), (const bf16_t*)(p.ws + WS_WBRD)};
          pg8::DualOrder S2; S2.init(NLAT, DM, (int)gridDim.x, VCU()); ep::EpiY2 E{p.ws};
          pg8::gemm_phase<ep::EpiY2, pg8::DualOrder, true, true>((PG8_LAS unsigned char*)smem, g, S2, E, wv); }
#endif
    }
#endif
    SEAM(5);
#ifndef SK7
    if (IN(6)) {
        pg8::Gemm g{(const bf16_t*)(p.ws + WS_Y), (const bf16_t*)(p.ws + WS_WOUTT), NLAT, DM, DM, nullptr, nullptr}; pg8::StaticOrder S; S.init(NLAT, DM, (int)gridDim.x, VCU());
        ep::EpiOut E{p.x, p.out, (const float*)(p.ws + WS_MOD)};
        pg8::gemm_phase<ep::EpiOut, pg8::StaticOrder, true, true>((PG8_LAS unsigned char*)smem, g, S, E, wv);
#if PROBE == 9
        pg8::gemm_phase<ep::EpiOut, pg8::StaticOrder, true, true>((PG8_LAS unsigned char*)smem, g, S, E, wv);
#endif
#if PROBE == 8
        pg8::gemm_phase<ep::EpiOut, pg8::StaticOrder, true, true>((PG8_LAS unsigned char*)smem, g, S, E, wv);
#if PROBE == 9
        pg8::gemm_phase<ep::EpiOut, pg8::StaticOrder, true, true>((PG8_LAS unsigned char*)smem, g, S, E, wv);
#endif
#endif
    }
#endif
}

extern "C" void kernel_launch(void* const* d_in, const int* in_sizes, int n_in, void* d_out, int out_size, void* d_ws, size_t ws_size, hipStream_t stream) {
    static int grid = 0;
    if (grid == 0) {
        if (n_in != 17 || out_size != NLAT * DM || ws_size < WS_END) { fprintf(stderr, "kernel_launch: unexpected shapes n_in %d out %d ws %zu\n", n_in, out_size, ws_size); grid = -1; return; }
        int dev = 0, cus = 0, per_cu = 0;
        hipGetDevice(&dev);
        hipDeviceGetAttribute(&cus, hipDeviceAttributeMultiprocessorCount, dev);
        hipFuncSetAttribute((const void*)fwd_kernel, hipFuncAttributeMaxDynamicSharedMemorySize, LDS_BYTES);
        hipOccupancyMaxActiveBlocksPerMultiprocessor(&per_cu, (const void*)fwd_kernel, NTHREADS, LDS_BYTES);
        if (per_cu < 1) { fprintf(stderr, "kernel_launch: occupancy query says %d blocks per CU\n", per_cu); per_cu = 1; }
        grid = cus * per_cu;
        (void)hipGetLastError();
    }
    if (grid < 0) return;
    hipMemsetAsync((char*)d_ws + WS_MOD, 0, WS_ZERO_BYTES, stream);
    Params p{};
    p.x = (const float*)d_in[0]; p.c = (const float*)d_in[1]; p.ctx = (const float*)d_in[2]; p.c_ctx = (const float*)d_in[3];
    p.w_ada = (const float*)d_in[4]; p.b_ada = (const float*)d_in[5]; p.w_in = (const float*)d_in[6]; p.w_dec = (const float*)d_in[7];
    p.b_dec = (const float*)d_in[8]; p.gla_norm = (const float*)d_in[9]; p.qn = (const float*)d_in[10]; p.kn = (const float*)d_in[11];
    p.dlam = (const float*)d_in[12]; p.dnorm = (const float*)d_in[13]; p.w_brg = (const float*)d_in[14]; p.w_brd = (const float*)d_in[15];
    p.w_out = (const float*)d_in[16];
    p.out = (float*)d_out; p.ws = (unsigned char*)d_ws; p.ph_lo = 0; p.ph_hi = 7;
    void* args[] = {&p};
    hipError_t e = hipLaunchCooperativeKernel((const void*)fwd_kernel, dim3(grid), dim3(NTHREADS), args, LDS_BYTES, stream);
    if (e != hipSuccess) fprintf(stderr, "cooperative launch failed: %s (grid %d)\n", hipGetErrorString(e), grid);
}
```

```cpp
#include <hip/hip_runtime.h>
#include <hip/hip_cooperative_groups.h>
#include <cstdio>
#include <cstdint>
namespace cg = cooperative_groups;

typedef unsigned short bf16_t;
typedef float f32x4 __attribute__((ext_vector_type(4)));
typedef unsigned u32x4 __attribute__((ext_vector_type(4)));
typedef unsigned u32x2 __attribute__((ext_vector_type(2)));

constexpr int DM = 1024, NB = 4, SEQ = 8192, CTXL = 256;
constexpr int NLAT = NB * SEQ, NCTX = NB * CTXL, NROW = NLAT + NCTX;
constexpr int INW = 9248;
constexpr float EPS = 1e-6f;
constexpr float LOG2E = 1.4426950408889634f;
constexpr float QC2 = 0.125f * LOG2E;
constexpr float LAM_INIT = 0.2f;
constexpr int C_GQ = 0, C_GK = 512, C_GV = 1024, C_GG = 2048, C_LR = 3072, C_DQ = 3104, C_DK = 4128, C_DV = 5152, C_DG = 6176, C_MG = 7200, C_MD = 8224;

constexpr size_t MiB = 1u << 20;
constexpr size_t WS_MOD = 0;
constexpr size_t WS_CTR = 61440;
constexpr size_t WS_BAR = 65536;
constexpr size_t WS_ZERO_BYTES = 81920;
constexpr size_t WS_TAB = 81920;
constexpr size_t WS_RSTDG = 128 * 1024;
constexpr size_t WS_WINT = 1 * MiB, WS_WBRT = 21 * MiB, WS_WOUTT = 25 * MiB;
constexpr size_t WS_H = 28 * MiB;
constexpr size_t WS_GQ = 94 * MiB;
constexpr size_t WS_GK = 127 * MiB;
constexpr size_t WS_A = WS_GQ;
constexpr size_t WS_GV = 160 * MiB;
constexpr size_t WS_SG = WS_GV;
constexpr size_t WS_DK = 226 * MiB;
constexpr size_t WS_SD = WS_DK;
constexpr size_t WS_DV = 292 * MiB;
constexpr size_t WS_Y = WS_DV;
constexpr size_t WS_DQ = 358 * MiB;
constexpr size_t WS_LR = 422 * MiB;
constexpr size_t WS_LAT = 427 * MiB;
constexpr size_t WS_END = 493 * MiB;

#define PROBE 0
constexpr int NTHREADS = 512;
constexpr int LDS_BYTES = 163840;

struct Params {
    const float *x, *c, *ctx, *c_ctx, *w_ada, *b_ada, *w_in, *w_dec, *b_dec, *gla_norm, *qn, *kn, *dlam, *dnorm, *w_brg, *w_brd, *w_out;
    float* out; unsigned char* ws;
    int ph_lo, ph_hi;
};

__device__ __forceinline__ float bf2f(bf16_t v) { return __uint_as_float(((unsigned)v) << 16); }
__device__ __forceinline__ unsigned f2bf(float f) { unsigned u = __float_as_uint(f); return (u + 0x7fffu + ((u >> 16) & 1u)) >> 16; }
__device__ __forceinline__ unsigned pk2(float lo, float hi) { return f2bf(lo) | (f2bf(hi) << 16); }
__device__ __forceinline__ float siluf(float v) { return v / (1.f + expf(-v)); }
__device__ __forceinline__ float sigmf(float v) { return 1.f / (1.f + expf(-v)); }
__device__ __forceinline__ float logsigf(float z) { return fminf(z, 0.f) - log1pf(expf(-fabsf(z))); }
__device__ __forceinline__ float wave_sum(float v) {
#pragma unroll
    for (int o = 1; o < 64; o <<= 1) v += __shfl_xor(v, o);
    return v;
}
__device__ __forceinline__ float lam_value(const float* dl) {
    float s1 = 0.f, s2 = 0.f;
    for (int i = 0; i < 64; ++i) { s1 += dl[i] * dl[64 + i]; s2 += dl[128 + i] * dl[192 + i]; }
    return expf(s1) - expf(s2) + LAM_INIT;
}
__device__ __forceinline__ float attn_shift(const float* qn, const float* kn) {
    float mq = 0.f, mk = 0.f;
    for (int i = 0; i < 64; ++i) { mq = fmaxf(mq, fabsf(qn[i])); mk = fmaxf(mk, fabsf(kn[i])); }
    return 8.f * LOG2E * mq * mk * 1.01f + 0.1f;
}


__device__ __forceinline__ int lane_id() { return (int)__builtin_amdgcn_mbcnt_hi(~0u, __builtin_amdgcn_mbcnt_lo(~0u, 0u)); }
#define GET_TID(ws_) ((ws_) * 64 + lane_id())

#define LAS __attribute__((address_space(3)))
#define XB_TMO      128
#define XB_XCNT(j)  (256  + 64 * (j))
#define XB_XSUB(j)  (1280 + 64 * (j))
#define XB_XGEN(j)  (2304 + 64 * (j))
#define XB_TOP      3328
#define XB_TOPGEN   3392
#define XCD_BAR_WORDS 3456
#define XB_SPIN_CAP (1u << 18)

__device__ __forceinline__ unsigned xb_ld(unsigned* p)              { return __hip_atomic_load(p, __ATOMIC_RELAXED, __HIP_MEMORY_SCOPE_AGENT); }
__device__ __forceinline__ unsigned xb_add(unsigned* p, unsigned v) { return __hip_atomic_fetch_add(p, v, __ATOMIC_RELAXED, __HIP_MEMORY_SCOPE_AGENT); }
__device__ __forceinline__ unsigned xb_xcc_id() { return (unsigned)__builtin_amdgcn_s_getreg((3 << 11) | 20) & 0xFu; }
#define XB_SPIN(cond, bar) do { unsigned _sp = 0; while (cond) { __builtin_amdgcn_s_sleep(1); \
    if ((++_sp & 255u) == 0u) { if (xb_ld(&(bar)[XB_TMO])) break; if (_sp > XB_SPIN_CAP) { atomicAdd(&(bar)[XB_TMO], 1u); break; } } } } while (0)

struct XcdBarrier {
    unsigned* bar; unsigned x;
    volatile LAS unsigned* st;
};

__device__ __forceinline__ XcdBarrier xcd_barrier_post(unsigned* bar, volatile LAS unsigned* st, bool tid0, unsigned& rank) {
    XcdBarrier b; b.bar = bar; b.x = xb_xcc_id(); b.st = st;
    rank = 0u; if (tid0) rank = xb_add(&bar[XB_XCNT(b.x)], 1u);
    return b;
}
__device__ __forceinline__ void xcd_barrier_complete(unsigned* bar, unsigned x, unsigned& nloc, unsigned& nx) {
    const unsigned G = gridDim.x * gridDim.y * gridDim.z;
    unsigned sum, cnt, mine, sp = 0u;
    for (;;) {
        sum = 0u; cnt = 0u; mine = 0u;
#pragma unroll
        for (unsigned j = 0; j < 16; ++j) { const unsigned c = xb_ld(&bar[XB_XCNT(j)]); sum += c; cnt += (c > 0u) ? 1u : 0u; mine = (j == x) ? c : mine; }
        if (sum == G) break;
        __builtin_amdgcn_s_sleep(1);
        if ((++sp & 255u) == 0u) { if (xb_ld(&bar[XB_TMO])) break; if (sp > XB_SPIN_CAP) { atomicAdd(&bar[XB_TMO], 1u); break; } }
    }
    nloc = mine > 0u ? mine : 1u; nx = cnt > 0u ? cnt : 1u;
}

__device__ __forceinline__ void xcd_barrier(const XcdBarrier& b, bool tid0, bool wait = true) {
    asm volatile("s_waitcnt vmcnt(0)" ::: "memory");
    __syncthreads();
    if (tid0) {
        unsigned* bar = b.bar;
        __builtin_amdgcn_s_waitcnt(0);
        unsigned nloc = b.st[0], nx = b.st[1];
        if (nloc == 0u) { xcd_barrier_complete(bar, b.x, nloc, nx); b.st[0] = nloc; b.st[1] = nx; }
        const unsigned old = xb_add(&bar[XB_XSUB(b.x)], 1u);
        const unsigned gen = old / nloc;
        if (old + 1u == (gen + 1u) * nloc) {
            __builtin_amdgcn_fence(__ATOMIC_RELEASE, "agent");
            asm volatile("s_waitcnt vmcnt(0)" ::: "memory");
            const unsigned og = xb_add(&bar[XB_TOP], 1u);
            const unsigned tg = og / nx;
            if (og + 1u == (tg + 1u) * nx) xb_add(&bar[XB_TOPGEN], 1u);
            else XB_SPIN(xb_ld(&bar[XB_TOPGEN]) <= tg, bar);
            __builtin_amdgcn_fence(__ATOMIC_ACQUIRE, "agent");
            xb_add(&bar[XB_XGEN(b.x)], 1u);
            asm volatile("s_waitcnt vmcnt(0)" ::: "memory");
        } else if (wait) {
            XB_SPIN(xb_ld(&bar[XB_XGEN(b.x)]) <= gen, bar);
            __builtin_amdgcn_fence(__ATOMIC_ACQUIRE, "agent");
            asm volatile("s_waitcnt vmcnt(0)" ::: "memory");
        }
    }
    __syncthreads();
}


__device__ __forceinline__ void p0a_naive(const Params& p, int wv, unsigned char* smem) {
    int tid = GET_TID(wv); asm volatile("" : "+v"(tid)); const int lane = tid & 63, wave = tid >> 6;
    const int gw = blockIdx.x * 8 + wave, NGW = gridDim.x * 8;
    float* MOD = (float*)(p.ws + WS_MOD);
    float* SC = (float*)(smem + 131072);
    for (int e = tid; e < 5 * 1024; e += NTHREADS) SC[e] = siluf(e < 4096 ? p.c[e] : p.c_ctx[e - 4096]);
    __syncthreads();
    for (int it = gw; it < 3072; it += NGW) {
        const int cc = it % 48, ks = it / 48, n = cc * 64 + lane;
        float a0 = 0.f, a1 = 0.f, a2 = 0.f, a3 = 0.f, a4 = 0.f;
        float wv_[16];
#pragma unroll
        for (int j = 0; j < 16; ++j) wv_[j] = p.w_ada[(size_t)(ks * 16 + j) * 3072 + n];
#pragma unroll
        for (int j = 0; j < 16; ++j) { const int k = ks * 16 + j; const float w = wv_[j];
            a0 += SC[k] * w; a1 += SC[1024 + k] * w; a2 += SC[2048 + k] * w; a3 += SC[3072 + k] * w; a4 += SC[4096 + k] * w;
        }
        if (ks == 0) { const float bb = p.b_ada[n]; a0 += bb; a1 += bb; a2 += bb; a3 += bb; a4 += bb; }
        atomicAdd(&MOD[n], a0); atomicAdd(&MOD[3072 + n], a1); atomicAdd(&MOD[2 * 3072 + n], a2); atomicAdd(&MOD[3 * 3072 + n], a3); atomicAdd(&MOD[4 * 3072 + n], a4);
    }
    float* TAB = (float*)(p.ws + WS_TAB);
    const int gt = blockIdx.x * NTHREADS + tid;
    if (gt < 2048) {
        const int pos = gt >> 4, i = gt & 15;
        const float inv = powf(10000.f, -(float)(2 * i) / 32.f);
        const float ang = (float)pos * inv;
        TAB[gt] = cosf(ang); TAB[2048 + gt] = sinf(ang);
    }
}
__device__ __forceinline__ void p0b_norm(const Params& p, int wv) {
    int tid = GET_TID(wv); asm volatile("" : "+v"(tid)); const int lane = tid & 63, wave = tid >> 6;
    const int gw = blockIdx.x * 8 + wave, NGW = gridDim.x * 8;
    const float* MOD = (const float*)(p.ws + WS_MOD);
    bf16_t* H = (bf16_t*)(p.ws + WS_H);
#define P0B_SRC(r_) ((r_) < NLAT ? p.x + (size_t)(r_) * DM : p.ctx + (size_t)((r_) - NLAT) * DM)
    f32x4 vn[2][2];
    if (gw < NROW) { const float* xr = P0B_SRC(gw);
#pragma unroll
        for (int j = 0; j < 2; ++j)
#pragma unroll
            for (int q = 0; q < 2; ++q) vn[j][q] = *(const f32x4*)(xr + 512 * j + 8 * lane + 4 * q); }
    for (int row = gw; row < NROW; row += NGW) {
        const int mr = row < NLAT ? row >> 13 : 4;
        f32x4 v[2][2]; float ss = 0.f;
#pragma unroll
        for (int j = 0; j < 2; ++j)
#pragma unroll
            for (int q = 0; q < 2; ++q) v[j][q] = vn[j][q];
        if (row + NGW < NROW) { const float* xr = P0B_SRC(row + NGW);
#pragma unroll
            for (int j = 0; j < 2; ++j)
#pragma unroll
                for (int q = 0; q < 2; ++q) vn[j][q] = *(const f32x4*)(xr + 512 * j + 8 * lane + 4 * q); }
#pragma unroll
        for (int j = 0; j < 2; ++j)
#pragma unroll
            for (int q = 0; q < 2; ++q) ss += v[j][q].x * v[j][q].x + v[j][q].y * v[j][q].y + v[j][q].z * v[j][q].z + v[j][q].w * v[j][q].w;
        ss = wave_sum(ss);
        const float rstd = rsqrtf(ss * (1.f / DM) + EPS);
#pragma unroll
        for (int j = 0; j < 2; ++j) {
            const int k = 512 * j + 8 * lane;
            u32x4 o;
            { const f32x4 sh = *(const f32x4*)(MOD + mr * 3072 + k), sc = *(const f32x4*)(MOD + mr * 3072 + 1024 + k); const f32x4 h = v[j][0] * rstd * (sc + 1.f) + sh; o.x = pk2(h.x, h.y); o.y = pk2(h.z, h.w); }
            { const f32x4 sh = *(const f32x4*)(MOD + mr * 3072 + k + 4), sc = *(const f32x4*)(MOD + mr * 3072 + 1024 + k + 4); const f32x4 h = v[j][1] * rstd * (sc + 1.f) + sh; o.z = pk2(h.x, h.y); o.w = pk2(h.z, h.w); }
            *(u32x4*)(H + (size_t)row * DM + k) = o;
        }
    }
}

namespace fa {
using bf16x8 = __attribute__((ext_vector_type(8))) short;
using s16x4  = __attribute__((ext_vector_type(4))) short;
using f32x16 = __attribute__((ext_vector_type(16))) float;
constexpr int KVBLK = 64;
#define FA_SBAR() __builtin_amdgcn_sched_barrier(0)
__device__ __forceinline__ int crow(int r, int hi) { return (r & 3) + 8 * (r >> 2) + 4 * hi; }
typedef float f32x2_t __attribute__((ext_vector_type(2))); typedef __bf16 bf16x2_t __attribute__((ext_vector_type(2)));
__device__ __forceinline__ unsigned cvtpk(float lo, float hi) { f32x2_t v = {lo, hi}; bf16x2_t bb = __builtin_convertvector(v, bf16x2_t); return __builtin_bit_cast(unsigned, bb); }
__device__ __forceinline__ int v_st(int k, int c) { const int kk = (k & ~0xC) | ((k & 4) << 1) | ((k & 8) >> 1); return ((kk >> 3) * 4 + (c >> 5)) * 512 + ((kk & 7) * 32 + (c & 31)) * 2; }
__device__ __forceinline__ int v_rd_base(int lane) { return ((lane & 3) << 3) | (((lane >> 2) & 3) << 6) | (((lane >> 4) & 1) << 5) | (((lane >> 5) & 1) << 8); }
__device__ __forceinline__ int kvrow(int b, int j) { return j < 4 ? NLAT + b * CTXL + 64 * j : b * SEQ + 64 * (j - 4); }

typedef short v4i16_t __attribute__((ext_vector_type(4)));
#define FA_LAS __attribute__((address_space(3)))
__device__ __forceinline__ s16x4 vtr(const FA_LAS char* p) { return __builtin_bit_cast(s16x4, __builtin_amdgcn_ds_read_tr16_b64_v4i16((FA_LAS v4i16_t*)p)); }
#define FA_PKF(Lo, Hi) (bf16x8){Lo[0], Lo[1], Lo[2], Lo[3], Hi[0], Hi[1], Hi[2], Hi[3]}

constexpr int KRING = 0, VRING = 3 * 16384, WSF_OFF = 6 * 16384;
template <bool SHIFT>
__device__ __forceinline__ void attn_unit2(int b, int h, int qb, bf16_t* QB, bf16_t* OBN, const bf16_t* __restrict__ Kg, const bf16_t* __restrict__ Vg,
                                           const float* __restrict__ dnorm, float lam, float negm, char* lds, int wv) {
    int tid = GET_TID(wv); asm volatile("" : "+v"(tid));
    const int wid = wv, lane = tid & 63, r32 = lane & 31, hi = lane >> 5, wq = wid & 3, sidx = wid >> 2;
    FA_LAS char* L = (FA_LAS char*)lds;
    float* wsf = (float*)(lds + WSF_OFF) + wid * 64;
    float l_reg = 0.f; f32x16 o[4] = {}; bf16x8 qr[4];
    const int qrow0 = b * SEQ + qb * 128 + wq * 32;
    char* QBc = (char*)QB;
    {
        const unsigned qo = ((unsigned)(qrow0 + r32) * DM + 128 * h + 64 * sidx + hi * 8) * 2u;
#pragma unroll
        for (int d0 = 0; d0 < 4; ++d0) qr[d0] = *reinterpret_cast<const bf16x8*>(QBc + qo + d0 * 32);
    }
    const char* Kc = (const char*)Kg; const char* Vc = (const char*)Vg;
    const unsigned ksrc = (unsigned)lane * 2048u + 256u * h + (unsigned)(2 * wid) * 16u;
    const unsigned vsrc = (unsigned)(16 * ((2 * wid) & 3) + (lane >> 2)) * 2048u + 256u * h + (unsigned)(32 * ((2 * wid) >> 2) + (lane & 3) * 8) * 2u;
    const int dmaoff = (2 * wid) * 1024;
#define A2_DMA_K(t, slotoff) do { const char* kp_ = Kc + (unsigned)kvrow(b, (t)) * 2048u + ksrc; FA_LAS char* sl_ = L + KRING + (slotoff) + dmaoff; \
        __builtin_amdgcn_global_load_lds((const unsigned*)(kp_), (FA_LAS unsigned*)(sl_), 16, 0, 0); \
        __builtin_amdgcn_global_load_lds((const unsigned*)(kp_ + 16), (FA_LAS unsigned*)(sl_ + 1024), 16, 0, 0); } while (0)
#define A2_DMA_V(t, slotoff) do { const char* vp_ = Vc + (unsigned)kvrow(b, (t)) * 2048u + vsrc; FA_LAS char* sl_ = L + VRING + (slotoff) + dmaoff; \
        __builtin_amdgcn_global_load_lds((const unsigned*)(vp_), (FA_LAS unsigned*)(sl_), 16, 0, 0); \
        __builtin_amdgcn_global_load_lds((const unsigned*)(vp_ + 16 * 2048), (FA_LAS unsigned*)(sl_ + 1024), 16, 0, 0); } while (0)
#define A2_DMA_K1(t, slotoff, i) do { const char* kp_ = Kc + (unsigned)kvrow(b, (t)) * 2048u + ksrc + (i) * 16; FA_LAS char* sl_ = L + KRING + (slotoff) + dmaoff + (i) * 1024; \
        __builtin_amdgcn_global_load_lds((const unsigned*)(kp_), (FA_LAS unsigned*)(sl_), 16, 0, 0); } while (0)
#define A2_DMA_V1(t, slotoff, i) do { const char* vp_ = Vc + (unsigned)kvrow(b, (t)) * 2048u + vsrc + (i) * (16 * 2048); FA_LAS char* sl_ = L + VRING + (slotoff) + dmaoff + (i) * 1024; \
        __builtin_amdgcn_global_load_lds((const unsigned*)(vp_), (FA_LAS unsigned*)(sl_), 16, 0, 0); } while (0)
#define A2_WBAR(N) asm volatile("s_waitcnt vmcnt(" #N ") lgkmcnt(0)\n\ts_barrier" ::: "memory")
    const FA_LAS char* kp0 = L + KRING + (8 * sidx + hi) * 1024 + r32 * 16;
    const FA_LAS char* vp0 = L + VRING + ((lane >> 4) & 1) * 32 + (lane & 3) * 8 + (4 * hi + ((lane & 15) >> 2)) * 64;
    constexpr int NT = (CTXL + SEQ) / KVBLK;
    bf16x8 kf[8]; s16x4 vlo[8], vhi[8]; u32x4 pw0, pw1, pw2, pw3; f32x16 pA0, pA1, pB0, pB1;
    const f32x16 ZERO = {};
    int sl_prev = 0, sl_cur = 0, sl_next = 16384;
#define A2_ROT() do { sl_prev = sl_cur; sl_cur = sl_next; sl_next = (sl_next == 32768) ? 0 : sl_next + 16384; } while (0)
#define A2_KLOAD2(kp, j) do { kf[2 * (j)] = *(const FA_LAS bf16x8*)((kp) + (j) * 2048); kf[2 * (j) + 1] = *(const FA_LAS bf16x8*)((kp) + (j) * 2048 + 512); } while (0)
#define A2_VRD(i, fi) do { vlo[i] = vtr(vp_ + ((fi) & 3) * 4096 + ((fi) >> 2) * 1024); vhi[i] = vtr(vp_ + ((fi) & 3) * 4096 + ((fi) >> 2) * 1024 + 512); } while (0)
#define A2_VFR(i) (bf16x8){vlo[i][0], vlo[i][1], vlo[i][2], vlo[i][3], vhi[i][0], vhi[i][1], vhi[i][2], vhi[i][3]}
#define A2_PIN(x) asm volatile("" : "+v"(x))
#define A2_PAF(k) __builtin_bit_cast(bf16x8, pw##k)
#define A2_GAPA(MF, A0, A1, A2, A3, W0, W1, PW) do { MF; sacc += A0; sacc += A1; sacc += A2; sacc += A3; A2_PIN(sacc); W0; W1; A2_PIN(PW); FA_SBAR(); } while (0)
#define A2_GAPB(MF, X, B) do { MF; X[B] = __builtin_amdgcn_exp2f(X[B]); X[B + 1] = __builtin_amdgcn_exp2f(X[B + 1]); A2_PIN(X); FA_SBAR(); } while (0)
#define A2_KRD(G, j) do { if (G) { A2_KLOAD2(kp0 + sl_next, j); FA_SBAR(); } } while (0)
#define A2_PKW(P, B) cvtpk(P[B], P[B + 1])
#define A2_STEP(C0, C1, P0, P1, t, GK, GV, GL) do { FA_SBAR(); \
        const FA_LAS char* vp_ = vp0 + sl_prev; float sacc = P0[0] + P0[1]; \
        A2_VRD(0, 0); FA_SBAR(); A2_GAPA(C0 = __builtin_amdgcn_mfma_f32_32x32x16_bf16(kf[0], qr[0], ZERO, 0, 0, 0), P0[2], P0[3], P0[4], P0[5],     pw0[0] = A2_PKW(P0, 0), pw0[1] = A2_PKW(P0, 2), pw0); \
        A2_VRD(1, 1); FA_SBAR(); A2_GAPA(C1 = __builtin_amdgcn_mfma_f32_32x32x16_bf16(kf[1], qr[0], ZERO, 0, 0, 0), P0[6], P0[7], P0[8], P0[9],     pw0[2] = A2_PKW(P0, 4), pw0[3] = A2_PKW(P0, 6), pw0); \
        A2_VRD(2, 2); FA_SBAR(); A2_GAPA(C0 = __builtin_amdgcn_mfma_f32_32x32x16_bf16(kf[2], qr[1], C0, 0, 0, 0),   P0[10], P0[11], P0[12], P0[13], pw1[0] = A2_PKW(P0, 8), pw1[1] = A2_PKW(P0, 10), pw1); \
        A2_VRD(3, 3); FA_SBAR(); A2_GAPA(C1 = __builtin_amdgcn_mfma_f32_32x32x16_bf16(kf[3], qr[1], C1, 0, 0, 0),   P0[14], P0[15], P1[0], P1[1],   pw1[2] = A2_PKW(P0, 12), pw1[3] = A2_PKW(P0, 14), pw1); \
        A2_VRD(4, 4); FA_SBAR(); A2_GAPA(C0 = __builtin_amdgcn_mfma_f32_32x32x16_bf16(kf[4], qr[2], C0, 0, 0, 0),   P1[2], P1[3], P1[4], P1[5],     pw2[0] = A2_PKW(P1, 0), pw2[1] = A2_PKW(P1, 2), pw2); \
        A2_VRD(5, 5); FA_SBAR(); A2_GAPA(C1 = __builtin_amdgcn_mfma_f32_32x32x16_bf16(kf[5], qr[2], C1, 0, 0, 0),   P1[6], P1[7], P1[8], P1[9],     pw2[2] = A2_PKW(P1, 4), pw2[3] = A2_PKW(P1, 6), pw2); \
        A2_VRD(6, 6); FA_SBAR(); A2_GAPA(C0 = __builtin_amdgcn_mfma_f32_32x32x16_bf16(kf[6], qr[3], C0, 0, 0, 0),   P1[10], P1[11], P1[12], P1[13], pw3[0] = A2_PKW(P1, 8), pw3[1] = A2_PKW(P1, 10), pw3); \
        A2_VRD(7, 7); FA_SBAR(); A2_GAPA(C1 = __builtin_amdgcn_mfma_f32_32x32x16_bf16(kf[7], qr[3], C1, 0, 0, 0),   P1[14], P1[15], 0.f, 0.f,       pw3[2] = A2_PKW(P1, 12), pw3[3] = A2_PKW(P1, 14), pw3); \
        l_reg += sacc; \
        if (SHIFT) { _Pragma("unroll") for (int r = 0; r < 16; ++r) { C0[r] += negm; C1[r] += negm; } } \
        FA_SBAR(); \
        A2_GAPB(o[0] = __builtin_amdgcn_mfma_f32_32x32x16_bf16(A2_PAF(0), A2_VFR(0), o[0], 0, 0, 0), C0, 0);  A2_VRD(0, 8);  FA_SBAR(); \
        A2_GAPB(o[1] = __builtin_amdgcn_mfma_f32_32x32x16_bf16(A2_PAF(0), A2_VFR(1), o[1], 0, 0, 0), C0, 2);  A2_VRD(1, 9);  FA_SBAR(); \
        A2_GAPB(o[2] = __builtin_amdgcn_mfma_f32_32x32x16_bf16(A2_PAF(0), A2_VFR(2), o[2], 0, 0, 0), C0, 4);  A2_VRD(2, 10); FA_SBAR(); \
        A2_KRD(GL, 0); A2_GAPB(o[3] = __builtin_amdgcn_mfma_f32_32x32x16_bf16(A2_PAF(0), A2_VFR(3), o[3], 0, 0, 0), C0, 6);  A2_VRD(3, 11); FA_SBAR(); \
        A2_GAPB(o[0] = __builtin_amdgcn_mfma_f32_32x32x16_bf16(A2_PAF(1), A2_VFR(4), o[0], 0, 0, 0), C0, 8);  A2_VRD(4, 12); FA_SBAR(); \
        A2_KRD(GL, 1); A2_GAPB(o[1] = __builtin_amdgcn_mfma_f32_32x32x16_bf16(A2_PAF(1), A2_VFR(5), o[1], 0, 0, 0), C0, 10); A2_VRD(5, 13); FA_SBAR(); \
        A2_GAPB(o[2] = __builtin_amdgcn_mfma_f32_32x32x16_bf16(A2_PAF(1), A2_VFR(6), o[2], 0, 0, 0), C0, 12); A2_VRD(6, 14); FA_SBAR(); \
        A2_KRD(GL, 2); A2_GAPB(o[3] = __builtin_amdgcn_mfma_f32_32x32x16_bf16(A2_PAF(1), A2_VFR(7), o[3], 0, 0, 0), C0, 14); A2_VRD(7, 15); FA_SBAR(); \
        if (GK) { A2_DMA_K1((t) + 3, sl_cur, 0); FA_SBAR(); } A2_GAPB(o[0] = __builtin_amdgcn_mfma_f32_32x32x16_bf16(A2_PAF(2), A2_VFR(0), o[0], 0, 0, 0), C1, 0); \
        A2_KRD(GL, 3); A2_GAPB(o[1] = __builtin_amdgcn_mfma_f32_32x32x16_bf16(A2_PAF(2), A2_VFR(1), o[1], 0, 0, 0), C1, 2); \
        if (GK) { A2_DMA_K1((t) + 3, sl_cur, 1); FA_SBAR(); } A2_GAPB(o[2] = __builtin_amdgcn_mfma_f32_32x32x16_bf16(A2_PAF(2), A2_VFR(2), o[2], 0, 0, 0), C1, 4); \
        A2_GAPB(o[3] = __builtin_amdgcn_mfma_f32_32x32x16_bf16(A2_PAF(2), A2_VFR(3), o[3], 0, 0, 0), C1, 6); \
        if (GV) { A2_DMA_V1((t) + 1, sl_next, 0); FA_SBAR(); } A2_GAPB(o[0] = __builtin_amdgcn_mfma_f32_32x32x16_bf16(A2_PAF(3), A2_VFR(4), o[0], 0, 0, 0), C1, 8); \
        A2_GAPB(o[1] = __builtin_amdgcn_mfma_f32_32x32x16_bf16(A2_PAF(3), A2_VFR(5), o[1], 0, 0, 0), C1, 10); \
        if (GV) { A2_DMA_V1((t) + 1, sl_next, 1); FA_SBAR(); } A2_GAPB(o[2] = __builtin_amdgcn_mfma_f32_32x32x16_bf16(A2_PAF(3), A2_VFR(6), o[2], 0, 0, 0), C1, 12); \
        A2_GAPB(o[3] = __builtin_amdgcn_mfma_f32_32x32x16_bf16(A2_PAF(3), A2_VFR(7), o[3], 0, 0, 0), C1, 14); \
    } while (0)
    A2_DMA_K(0, 0); A2_DMA_V(0, 0); A2_DMA_K(1, 16384); A2_DMA_K(2, 32768);
    A2_WBAR(6);
    {
        const FA_LAS char* kp_ = kp0;
#pragma unroll
        for (int d0 = 0; d0 < 4; ++d0) {
            const bf16x8 b0_ = *(const FA_LAS bf16x8*)(kp_ + d0 * 2048), b1_ = *(const FA_LAS bf16x8*)(kp_ + d0 * 2048 + 512);
            if (d0 == 0) { pA0 = __builtin_amdgcn_mfma_f32_32x32x16_bf16(b0_, qr[0], ZERO, 0, 0, 0); pA1 = __builtin_amdgcn_mfma_f32_32x32x16_bf16(b1_, qr[0], ZERO, 0, 0, 0); }
            else { pA0 = __builtin_amdgcn_mfma_f32_32x32x16_bf16(b0_, qr[d0], pA0, 0, 0, 0); pA1 = __builtin_amdgcn_mfma_f32_32x32x16_bf16(b1_, qr[d0], pA1, 0, 0, 0); }
        }
        if (SHIFT) {
#pragma unroll
            for (int r = 0; r < 16; ++r) { pA0[r] += negm; pA1[r] += negm; }
        }
#pragma unroll
        for (int r = 0; r < 16; ++r) { pA0[r] = __builtin_amdgcn_exp2f(pA0[r]); pA1[r] = __builtin_amdgcn_exp2f(pA1[r]); }
    }
    A2_WBAR(0);
    A2_DMA_K(3, 0); A2_DMA_V(1, 16384);
    A2_ROT();
    A2_KLOAD2(kp0 + sl_cur, 0); A2_KLOAD2(kp0 + sl_cur, 1); A2_KLOAD2(kp0 + sl_cur, 2); A2_KLOAD2(kp0 + sl_cur, 3);
    A2_WBAR(4);
    int t = 1;
    for (; t + 5 < NT; t += 2) {
        A2_STEP(pB0, pB1, pA0, pA1, t, true, true, true);     A2_WBAR(4); A2_ROT();
        A2_STEP(pA0, pA1, pB0, pB1, t + 1, true, true, true); A2_WBAR(4); A2_ROT();
    }
#define A2_ENDW(tt) do { if ((tt) + 3 < NT) { A2_WBAR(4); } else if ((tt) + 2 < NT) { A2_WBAR(2); } else { A2_WBAR(0); } } while (0)
    for (; t + 1 < NT; t += 2) {
        A2_STEP(pB0, pB1, pA0, pA1, t, (t + 3 < NT), (t + 1 < NT), (t + 1 < NT));         A2_ENDW(t);     A2_ROT();
        A2_STEP(pA0, pA1, pB0, pB1, t + 1, (t + 4 < NT), (t + 2 < NT), (t + 2 < NT));     A2_ENDW(t + 1); A2_ROT();
    }
    A2_STEP(pB0, pB1, pA0, pA1, NT - 1, false, false, false);
    {
        float sacc = pB0[0] + pB0[1];
#pragma unroll
        for (int r = 2; r < 16; ++r) sacc += pB0[r];
#pragma unroll
        for (int r = 0; r < 16; ++r) sacc += pB1[r];
        l_reg += sacc;
        pw0 = (u32x4){A2_PKW(pB0, 0), A2_PKW(pB0, 2), A2_PKW(pB0, 4), A2_PKW(pB0, 6)}; pw1 = (u32x4){A2_PKW(pB0, 8), A2_PKW(pB0, 10), A2_PKW(pB0, 12), A2_PKW(pB0, 14)};
        pw2 = (u32x4){A2_PKW(pB1, 0), A2_PKW(pB1, 2), A2_PKW(pB1, 4), A2_PKW(pB1, 6)}; pw3 = (u32x4){A2_PKW(pB1, 8), A2_PKW(pB1, 10), A2_PKW(pB1, 12), A2_PKW(pB1, 14)};
        const FA_LAS char* vp_ = vp0 + sl_cur;
#pragma unroll
        for (int d0 = 0; d0 < 4; ++d0) {
            const s16x4 l0_ = vtr(vp_ + d0 * 4096), h0_ = vtr(vp_ + d0 * 4096 + 512), l1_ = vtr(vp_ + d0 * 4096 + 1024), h1_ = vtr(vp_ + d0 * 4096 + 1536);
            const s16x4 l2_ = vtr(vp_ + d0 * 4096 + 2048), h2_ = vtr(vp_ + d0 * 4096 + 2560), l3_ = vtr(vp_ + d0 * 4096 + 3072), h3_ = vtr(vp_ + d0 * 4096 + 3584);
            o[d0] = __builtin_amdgcn_mfma_f32_32x32x16_bf16(A2_PAF(0), FA_PKF(l0_, h0_), o[d0], 0, 0, 0);
            o[d0] = __builtin_amdgcn_mfma_f32_32x32x16_bf16(A2_PAF(1), FA_PKF(l1_, h1_), o[d0], 0, 0, 0);
            o[d0] = __builtin_amdgcn_mfma_f32_32x32x16_bf16(A2_PAF(2), FA_PKF(l2_, h2_), o[d0], 0, 0, 0);
            o[d0] = __builtin_amdgcn_mfma_f32_32x32x16_bf16(A2_PAF(3), FA_PKF(l3_, h3_), o[d0], 0, 0, 0);
        }
    }
    { auto rr = __builtin_amdgcn_permlane32_swap(__float_as_uint(l_reg), __float_as_uint(l_reg), false, false); l_reg = __uint_as_float(rr[0]) + __uint_as_float(rr[1]); }
    if (hi == 0) wsf[r32] = 1.f / l_reg;
    asm volatile("s_waitcnt lgkmcnt(0)" ::: "memory");
    __syncthreads();
    unsigned* X = (unsigned*)lds + (wq * 32) * 64 + lane;
    if (sidx == 1) {
#pragma unroll
        for (int r = 0; r < 16; ++r) { const float il = wsf[crow(r, hi)];
            X[(0 * 16 + r) * 64] = cvtpk(o[0][r] * il, o[1][r] * il); X[(1 * 16 + r) * 64] = cvtpk(o[2][r] * il, o[3][r] * il); }
    }
    __syncthreads();
    if (sidx == 0) {
        const unsigned oo = ((unsigned)(qrow0 + 4 * hi) * DM + 128 * h + 4 * r32) * 2u;
        const float g0 = dnorm[r32], g1 = dnorm[32 + r32], g2 = dnorm[64 + r32], g3 = dnorm[96 + r32];
        float* SS = (float*)(lds + 32768) + wq * 1024 + hi * 512;
        float* TOT = (float*)(lds + 49152) + wq * 32 + hi * 16;
#pragma unroll
        for (int r = 0; r < 16; ++r) {
            const float il = wsf[crow(r, hi)];
            const unsigned w0 = X[(0 * 16 + r) * 64], w1 = X[(1 * 16 + r) * 64];
            const float v0 = o[0][r] * il - lam * __uint_as_float(w0 << 16), v1 = o[1][r] * il - lam * __uint_as_float(w0 & 0xffff0000u);
            const float v2 = o[2][r] * il - lam * __uint_as_float(w1 << 16), v3 = o[3][r] * il - lam * __uint_as_float(w1 & 0xffff0000u);
            o[0][r] = v0; o[1][r] = v1; o[2][r] = v2; o[3][r] = v3;
            SS[r * 32 + r32] = v0 * v0 + v1 * v1 + v2 * v2 + v3 * v3;
        }
        {
            const f32x4* rp = (const f32x4*)(SS + (r32 & 15) * 32 + (r32 >> 4) * 16);
            const f32x4 a = rp[0], bq = rp[1], c4 = rp[2], d4 = rp[3];
            float t = ((a[0] + a[1]) + (a[2] + a[3])) + ((bq[0] + bq[1]) + (bq[2] + bq[3])) + ((c4[0] + c4[1]) + (c4[2] + c4[3])) + ((d4[0] + d4[1]) + (d4[2] + d4[3]));
            t += __shfl_xor(t, 16);
            if (r32 < 16) TOT[r32] = t;
        }
        const f32x4 t0 = *(const f32x4*)(TOT), t1 = *(const f32x4*)(TOT + 4), t2 = *(const f32x4*)(TOT + 8), t3 = *(const f32x4*)(TOT + 12);
#pragma unroll
        for (int r = 0; r < 16; ++r) {
            const float ss = (r < 4 ? t0 : r < 8 ? t1 : r < 12 ? t2 : t3)[r & 3];
            const float rs = rsqrtf(ss * (1.f / 128.f) + EPS) * (1.f - LAM_INIT);
            u32x2 w; w.x = cvtpk(o[0][r] * rs * g0, o[1][r] * rs * g1); w.y = cvtpk(o[2][r] * rs * g2, o[3][r] * rs * g3);
            *(u32x2*)((char*)OBN + oo + (unsigned)((r & 3) + 8 * (r >> 2)) * (DM * 2u)) = w;
        }
    }
    __syncthreads();
}
}


typedef float f32x2h_t __attribute__((ext_vector_type(2))); typedef __bf16 bf16x2h_t __attribute__((ext_vector_type(2)));
__device__ __forceinline__ unsigned pk2_hw(float lo, float hi) { f32x2h_t v = {lo, hi}; bf16x2h_t bb = __builtin_convertvector(v, bf16x2h_t); return __builtin_bit_cast(unsigned, bb); }
__device__ __forceinline__ unsigned f2bf_hw(float f) { return pk2_hw(f, 0.f) & 0xffffu; }
__device__ __forceinline__ void p2a_logdecay(const Params& p, unsigned char* smem, int wv) {
    typedef float f32x16p __attribute__((ext_vector_type(16))); typedef short bf16x8p __attribute__((ext_vector_type(8)));
    int tid = GET_TID(wv); asm volatile("" : "+v"(tid));
    const int lane = tid & 63, r32 = lane & 31, hi = lane >> 5;
    const float* LR = (const float*)(p.ws + WS_LR);
    bf16_t* LAT = (bf16_t*)(p.ws + WS_LAT);
    (void)smem;
    for (int combo = blockIdx.x; combo < 256; combo += gridDim.x) {
        const int u = combo >> 3, tile = combo & 7, rb = tile & 1, cb = tile >> 1, dir = u & 1, h = (u >> 1) & 3, b = u >> 3;
        const int ca = 32 * cb + r32;
        bf16x8p whi, wlo;
#pragma unroll
        for (int j = 0; j < 8; ++j) { const float w = p.w_dec[(size_t)(dir * 16 + 8 * hi + j) * 512 + 128 * h + ca];
            const unsigned wh = f2bf_hw(w); const float rem = w - __uint_as_float(wh << 16); whi[j] = (short)wh; wlo[j] = (short)f2bf_hw(rem); }
        const float bdec = p.b_dec[dir * 512 + 128 * h + ca];
#define P2A_ROW(n_) ((n_) < 4 ? NLAT + b * CTXL + (dir ? CTXL - 1 - (64 * (n_) + 32 * rb + r32) : 64 * (n_) + 32 * rb + r32) \
                              : b * SEQ + (dir ? SEQ - 1 - (64 * ((n_) - 4) + 32 * rb + r32) : 64 * ((n_) - 4) + 32 * rb + r32))
        f32x4 an0 = {0.f, 0.f, 0.f, 0.f}, an1 = an0;
        if (wv < 132) { const float* ap = LR + (size_t)P2A_ROW(wv) * 32 + 16 * dir + 8 * hi; an0 = *(const f32x4*)ap; an1 = *(const f32x4*)(ap + 4); }
        for (int n = wv; n < 132; n += 8) {
            const f32x4 a0 = an0, a1 = an1;
            if (n + 8 < 132) { const float* ap = LR + (size_t)P2A_ROW(n + 8) * 32 + 16 * dir + 8 * hi; an0 = *(const f32x4*)ap; an1 = *(const f32x4*)(ap + 4); }
            bf16x8p ahi, alo;
#pragma unroll
            for (int j = 0; j < 8; ++j) { const float x = j < 4 ? a0[j] : a1[j - 4]; const unsigned xh = f2bf_hw(x); const float rem = x - __uint_as_float(xh << 16); ahi[j] = (short)xh; alo[j] = (short)f2bf_hw(rem); }
            f32x16p acc = {};
            acc = __builtin_amdgcn_mfma_f32_32x32x16_bf16(alo, whi, acc, 0, 0, 0);
            acc = __builtin_amdgcn_mfma_f32_32x32x16_bf16(ahi, wlo, acc, 0, 0, 0);
            acc = __builtin_amdgcn_mfma_f32_32x32x16_bf16(ahi, whi, acc, 0, 0, 0);
            unsigned pk[8];
#pragma unroll
            for (int g = 0; g < 4; ++g) {
                float l4[4];
#pragma unroll
                for (int e = 0; e < 4; ++e) { const float z = acc[4 * g + e] + bdec; l4[e] = (fminf(z, 0.f) - __logf(1.f + __expf(-fabsf(z)))) * (1.f / 16.f); }
                pk[2 * g] = pk2_hw(l4[0], l4[1]); pk[2 * g + 1] = pk2_hw(l4[2], l4[3]);
            }
            bf16_t* dst = LAT + ((size_t)((u * 132 + n) * 128 + ca) * 64 + 32 * rb + 8 * hi);
#pragma unroll
            for (int gp = 0; gp < 2; ++gp) {
                const auto s0 = __builtin_amdgcn_permlane32_swap(pk[4 * gp], pk[4 * gp + 2], false, false), s1 = __builtin_amdgcn_permlane32_swap(pk[4 * gp + 1], pk[4 * gp + 3], false, false);
                *(u32x4*)(dst + 16 * gp) = (u32x4){s0[0], s1[0], s0[1], s1[1]};
            }
        }
#undef P2A_ROW
    }
}

namespace fg {
using fa::bf16x8; using fa::s16x4; using fa::f32x16; using fa::crow; using fa::cvtpk;
typedef short v4i16_t __attribute__((ext_vector_type(4)));
typedef __attribute__((address_space(3))) const char* lds_cptr;
#define FG_LAS __attribute__((address_space(3)))
constexpr int L_LR = 0;
constexpr int L_GT = 4096;
constexpr int L_ER = 6144, L_EL = 6656, L_DEC = 7168;
constexpr int L_E1 = 8192;
constexpr int L_P = L_E1;
constexpr int QSTR = 272, PSTR = 144;
constexpr int L_QS = 40960, L_KS = 58368, L_QI = 75776;
constexpr int L_KST = 93184;
constexpr int L_VS = 109568;
constexpr int L_WD = 142336;
constexpr int L_BD = L_WD + 8192;
constexpr int L_END = L_BD + 512;
__device__ __forceinline__ s16x4 vtr(lds_cptr p) { return __builtin_bit_cast(s16x4, __builtin_amdgcn_ds_read_tr16_b64_v4i16((FG_LAS v4i16_t*)p)); }
__device__ __forceinline__ bf16x8 ldb128(lds_cptr p) { return *(const FG_LAS bf16x8*)p; }
__device__ __forceinline__ int rowmap(int b, int dir, int n, int i) {
    if (n < 4) { const int idx = 64 * n + i; return NLAT + b * CTXL + (dir ? CTXL - 1 - idx : idx); }
    const int idx = 64 * (n - 4) + i; return b * SEQ + (dir ? SEQ - 1 - idx : idx);
}
#define FG_PKF(L, H) (bf16x8){L[0], L[1], L[2], L[3], H[0], H[1], H[2], H[3]}

#define FG_LBAR() asm volatile("s_waitcnt lgkmcnt(0)\n\ts_barrier" ::: "memory")
__device__ __forceinline__ void gla_unit(const Params& p, int b, int h, int dir, unsigned char* smem, int wv) {
    int tid = GET_TID(wv); asm volatile("" : "+v"(tid));
    const int lane = tid & 63, wid = tid >> 6, r32 = lane & 31, hi = lane >> 5;
    const int ca = tid & 127, tg = tid >> 7;
    const int ib = tid >> 3, cg = tid & 7;
    FG_LAS char* L = (FG_LAS char*)smem;
    const char* GQ = (const char*)(p.ws + WS_GQ); const char* GK = (const char*)(p.ws + WS_GK); const char* GV = (const char*)(p.ws + WS_GV);
    const char* LR = (const char*)(p.ws + WS_LR);
    bf16_t* OUT = (bf16_t*)p.out + (size_t)dir * NLAT * DM;
    const char* LATu = (const char*)(p.ws + WS_LAT) + ((size_t)((b * 8 + h * 2 + dir) * 132) * 128 * 64 + (size_t)ca * 64 + 16 * tg) * 2;
    f32x16 S[4];
#pragma unroll
    for (int t = 0; t < 4; ++t) S[t] = f32x16{};
    u32x4 pq0, pq1, pk0, pk1, pv0, pv1, pv2, pv3, pla0, pla1;
#define FG_PREFETCH_QK(n) do { const unsigned row_ = (unsigned)rowmap(b, dir, (n), ib); \
        const char* qp_ = GQ + (row_ * 512u + 128u * h + 16u * cg) * 2u; pq0 = *(const u32x4*)qp_; pq1 = *(const u32x4*)(qp_ + 16); \
        const char* kp_ = GK + (row_ * 512u + 128u * h + 16u * cg) * 2u; pk0 = *(const u32x4*)kp_; pk1 = *(const u32x4*)(kp_ + 16); } while (0)
#define FG_PREFETCH_V(n) do { const unsigned row_ = (unsigned)rowmap(b, dir, (n), ib); \
        const char* vp_ = GV + (row_ * 1024u + 256u * h + 32u * cg) * 2u; pv0 = *(const u32x4*)vp_; pv1 = *(const u32x4*)(vp_ + 16); pv2 = *(const u32x4*)(vp_ + 32); pv3 = *(const u32x4*)(vp_ + 48); \
        const char* lp_ = LATu + (size_t)(n) * (128 * 64 * 2); pla0 = *(const u32x4*)lp_; pla1 = *(const u32x4*)(lp_ + 16); } while (0)
    FG_PREFETCH_QK(0); FG_PREFETCH_V(0);
    const int vimg = L_VS + (wid >> 2) * 16384 + (wid & 3) * 512 + fa::v_rd_base(lane);
    const int kstb = L_KST + fa::v_rd_base(lane);
    const int fbase = r32 * QSTR + 16 * hi, qibase = r32 * QSTR + 8 * hi, pwbase = 4 * hi * PSTR + 2 * r32, prbase = r32 * PSTR + 16 * hi;
    for (int n = 0; n < 132; ++n) {
        float cum[16];
        {
            const unsigned lw[8] = {pla0.x, pla0.y, pla0.z, pla0.w, pla1.x, pla1.y, pla1.z, pla1.w};
            float run = 0.f;
#pragma unroll
            for (int i2 = 0; i2 < 8; ++i2) {
                run += __uint_as_float(lw[i2] << 16); cum[2 * i2] = run;
                run += __uint_as_float(lw[i2] & 0xffff0000u); cum[2 * i2 + 1] = run;
            }
            *(FG_LAS float*)(L + L_GT + (tg * 128 + ca) * 4) = run;
        }
        FG_LBAR();
        {
            const float g0 = *(const FG_LAS float*)(L + L_GT + ca * 4), g1 = *(const FG_LAS float*)(L + L_GT + (128 + ca) * 4);
            const float g2 = *(const FG_LAS float*)(L + L_GT + (256 + ca) * 4), g3 = *(const FG_LAS float*)(L + L_GT + (384 + ca) * 4);
            const float ref = g0 + g1, last = (g0 + g1) + (g2 + g3);
            const float off = tg == 0 ? 0.f : tg == 1 ? g0 : tg == 2 ? g0 + g1 : (g0 + g1) + g2;
#pragma unroll
            for (int i = 0; i < 16; ++i) *(FG_LAS float*)(L + L_E1 + ((16 * tg + i) * 128 + ca) * 4) = __expf(cum[i] + off - ref);
            if (tg == 0) { *(FG_LAS float*)(L + L_ER + ca * 4) = __expf(ref); *(FG_LAS float*)(L + L_EL + ca * 4) = __expf(last - ref); *(FG_LAS float*)(L + L_DEC + ca * 4) = __expf(last); }
        }
        FG_LBAR();
        {
            { const int img = cg >> 2, cb = 32 * (cg & 3);
              *(FG_LAS u32x4*)(L + L_VS + img * 16384 + fa::v_st(ib, cb)) = pv0; *(FG_LAS u32x4*)(L + L_VS + img * 16384 + fa::v_st(ib, cb + 8)) = pv1;
              *(FG_LAS u32x4*)(L + L_VS + img * 16384 + fa::v_st(ib, cb + 16)) = pv2; *(FG_LAS u32x4*)(L + L_VS + img * 16384 + fa::v_st(ib, cb + 24)) = pv3; }
            unsigned qs[8], ks[8], qi[8], kt[8];
            const unsigned qw[8] = {pq0.x, pq0.y, pq0.z, pq0.w, pq1.x, pq1.y, pq1.z, pq1.w};
            const unsigned kw[8] = {pk0.x, pk0.y, pk0.z, pk0.w, pk1.x, pk1.y, pk1.z, pk1.w};
#pragma unroll
            for (int q4 = 0; q4 < 4; ++q4) {
                const f32x4 e1 = *(const FG_LAS f32x4*)(L + L_E1 + (ib * 128 + 16 * cg + 4 * q4) * 4);
                const f32x4 er = *(const FG_LAS f32x4*)(L + L_ER + (16 * cg + 4 * q4) * 4), el = *(const FG_LAS f32x4*)(L + L_EL + (16 * cg + 4 * q4) * 4);
#pragma unroll
                for (int e = 0; e < 2; ++e) {
                    const int wi = 2 * q4 + e;
                    const float qa = __uint_as_float(qw[wi] << 16), qb = __uint_as_float(qw[wi] & 0xffff0000u);
                    const float ka = __uint_as_float(kw[wi] << 16), kb = __uint_as_float(kw[wi] & 0xffff0000u);
                    const float ea = e1[2 * e], eb = e1[2 * e + 1];
                    const float ia = __builtin_amdgcn_rcpf(ea), ibv = __builtin_amdgcn_rcpf(eb);
                    const float qsa = qa * ea, qsb = qb * eb, ksa = ka * ia, ksb = kb * ibv;
                    qs[wi] = cvtpk(qsa, qsb); ks[wi] = cvtpk(ksa, ksb);
                    qi[wi] = cvtpk(qsa * er[2 * e], qsb * er[2 * e + 1]); kt[wi] = cvtpk(ksa * el[2 * e], ksb * el[2 * e + 1]);
                }
            }
            const int c0 = ib * QSTR + 32 * cg, c1 = c0 + 16;
            *(FG_LAS u32x4*)(L + L_QS + c0) = (u32x4){qs[0], qs[1], qs[2], qs[3]}; *(FG_LAS u32x4*)(L + L_QS + c1) = (u32x4){qs[4], qs[5], qs[6], qs[7]};
            *(FG_LAS u32x4*)(L + L_KS + c0) = (u32x4){ks[0], ks[1], ks[2], ks[3]}; *(FG_LAS u32x4*)(L + L_KS + c1) = (u32x4){ks[4], ks[5], ks[6], ks[7]};
            *(FG_LAS u32x4*)(L + L_QI + c0) = (u32x4){qi[0], qi[1], qi[2], qi[3]}; *(FG_LAS u32x4*)(L + L_QI + c1) = (u32x4){qi[4], qi[5], qi[6], qi[7]};
            *(FG_LAS u32x4*)(L + L_KST + fa::v_st(ib, 16 * cg)) = (u32x4){kt[0], kt[1], kt[2], kt[3]};
            *(FG_LAS u32x4*)(L + L_KST + fa::v_st(ib, 16 * cg + 8)) = (u32x4){kt[4], kt[5], kt[6], kt[7]};
        }
        FG_LBAR();
        if (n + 1 < 132) FG_PREFETCH_V(n + 1);
        if (wid < 3) {
            const int it = wid == 0 ? 0 : 1, jt = wid == 2 ? 1 : 0;
            f32x16 sc = f32x16{};
#pragma unroll
            for (int k4 = 0; k4 < 2; ++k4) {
                bf16x8 av[4], bv[4];
#pragma unroll
                for (int ks = 0; ks < 4; ++ks) { av[ks] = ldb128((lds_cptr)(L + L_QS + fbase + it * (32 * QSTR) + 32 * (4 * k4 + ks))); bv[ks] = ldb128((lds_cptr)(L + L_KS + fbase + jt * (32 * QSTR) + 32 * (4 * k4 + ks))); }
#pragma unroll
                for (int ks = 0; ks < 4; ++ks) sc = __builtin_amdgcn_mfma_f32_32x32x16_bf16(av[ks], bv[ks], sc, 0, 0, 0);
            }
#pragma unroll
            for (int r = 0; r < 16; ++r) {
                const int i = crow(r, hi);
                float v = sc[r]; if (it == jt && r32 > i) v = 0.f;
                *(FG_LAS bf16_t*)(L + L_P + pwbase + (32 * it + (r & 3) + 8 * (r >> 2)) * PSTR + 64 * jt) = (bf16_t)f2bf(v);
            }
        }
        bf16x8 vf[4];
#pragma unroll
        for (int ks = 0; ks < 4; ++ks) { const s16x4 lo = vtr((lds_cptr)(L + vimg + ks * 4096)), hh = vtr((lds_cptr)(L + vimg + ks * 4096 + 2048)); vf[ks] = FG_PKF(lo, hh); }
        f32x16 o0 = f32x16{}, o1 = f32x16{};
#pragma unroll
        for (int t = 0; t < 4; ++t) {
            u32x2 qa[2][2], qb[2][2];
#pragma unroll
            for (int s2 = 0; s2 < 2; ++s2) { const int ch = (4 * t + 2 * s2) * 16;
                qa[s2][0] = *(const FG_LAS u32x2*)(L + L_QI + qibase + ch); qa[s2][1] = *(const FG_LAS u32x2*)(L + L_QI + qibase + ch + 16);
                qb[s2][0] = *(const FG_LAS u32x2*)(L + L_QI + qibase + 32 * QSTR + ch); qb[s2][1] = *(const FG_LAS u32x2*)(L + L_QI + qibase + 32 * QSTR + ch + 16); }
#pragma unroll
            for (int s2 = 0; s2 < 2; ++s2) {
                u32x4 sw; sw.x = cvtpk(S[t][8 * s2 + 0], S[t][8 * s2 + 1]); sw.y = cvtpk(S[t][8 * s2 + 2], S[t][8 * s2 + 3]);
                sw.z = cvtpk(S[t][8 * s2 + 4], S[t][8 * s2 + 5]); sw.w = cvtpk(S[t][8 * s2 + 6], S[t][8 * s2 + 7]);
                const bf16x8 sb = __builtin_bit_cast(bf16x8, sw);
                { const u32x4 aw = {qa[s2][0].x, qa[s2][0].y, qa[s2][1].x, qa[s2][1].y}; o0 = __builtin_amdgcn_mfma_f32_32x32x16_bf16(__builtin_bit_cast(bf16x8, aw), sb, o0, 0, 0, 0); }
                { const u32x4 aw = {qb[s2][0].x, qb[s2][0].y, qb[s2][1].x, qb[s2][1].y}; o1 = __builtin_amdgcn_mfma_f32_32x32x16_bf16(__builtin_bit_cast(bf16x8, aw), sb, o1, 0, 0, 0); }
            }
        }
#pragma unroll
        for (int t = 0; t < 4; ++t) {
            s16x4 klo[4], khi[4];
#pragma unroll
            for (int ks = 0; ks < 4; ++ks) { klo[ks] = vtr((lds_cptr)(L + kstb + t * 512 + ks * 4096)); khi[ks] = vtr((lds_cptr)(L + kstb + t * 512 + ks * 4096 + 2048)); }
#pragma unroll
            for (int g = 0; g < 4; ++g) {
                const f32x4 dc = *(const FG_LAS f32x4*)(L + L_DEC + (32 * t + 8 * g + 4 * hi) * 4);
                S[t][4 * g + 0] *= dc[0]; S[t][4 * g + 1] *= dc[1]; S[t][4 * g + 2] *= dc[2]; S[t][4 * g + 3] *= dc[3];
            }
#pragma unroll
            for (int ks = 0; ks < 4; ++ks) S[t] = __builtin_amdgcn_mfma_f32_32x32x16_bf16(FG_PKF(klo[ks], khi[ks]), vf[ks], S[t], 0, 0, 0);
        }
        FG_LBAR();
        if (n + 1 < 132) FG_PREFETCH_QK(n + 1);
#pragma unroll
        for (int ks = 0; ks < 2; ++ks) {
            const bf16x8 a = ldb128((lds_cptr)(L + L_P + prbase + 32 * ks));
            o0 = __builtin_amdgcn_mfma_f32_32x32x16_bf16(a, vf[ks], o0, 0, 0, 0);
        }
#pragma unroll
        for (int ks = 0; ks < 4; ++ks) {
            const bf16x8 a = ldb128((lds_cptr)(L + L_P + prbase + 32 * PSTR + 32 * ks));
            o1 = __builtin_amdgcn_mfma_f32_32x32x16_bf16(a, vf[ks], o1, 0, 0, 0);
        }
        if (n >= 4) {
            const int i0 = 64 * (n - 4) + 4 * hi;
            const int rstep = dir ? -(DM * 2) : (DM * 2);
            const unsigned ob = ((unsigned)(b * SEQ + (dir ? SEQ - 1 - i0 : i0)) * DM + 256 * h + 32 * wid + r32) * 2u;
            char* OC = (char*)OUT;
#pragma unroll
            for (int r = 0; r < 16; ++r) {
                const int k = (r & 3) + 8 * (r >> 2);
                *(bf16_t*)(OC + (ob + (unsigned)(rstep * k))) = (bf16_t)f2bf(o0[r]);
                *(bf16_t*)(OC + (ob + (unsigned)(rstep * (k + 32)))) = (bf16_t)f2bf(o1[r]);
            }
        }
    }
#undef FG_PREFETCH_QK
#undef FG_PREFETCH_V
    __syncthreads();
}
}

template <bool LATE> __device__ __forceinline__ void p0_weights(const Params& p, unsigned char* smem, int wv);
__device__ __forceinline__ void p2_mixed(const Params& p, unsigned char* smem, int wv) {
#ifndef SK3G
    if (blockIdx.x < 32) { const int u = (int)blockIdx.x; fg::gla_unit(p, u >> 3, (u >> 1) & 3, u & 1, smem, wv);
#if PROBE == 3
        fg::gla_unit(p, u >> 3, (u >> 1) & 3, u & 1, smem, wv);
#endif
    }
#endif
#if PROBE == 6
    if (blockIdx.x < 32) return;
#endif
#ifndef SK3B
    unsigned* ctr = (unsigned*)(p.ws + WS_CTR);
    FG_LAS unsigned* slot = (FG_LAS unsigned*)(smem + LDS_BYTES - 64);
    const float lam = __uint_as_float(__builtin_amdgcn_readfirstlane(__float_as_uint(lam_value(p.dlam))));
    const float negm = __uint_as_float(__builtin_amdgcn_readfirstlane(__float_as_uint(-attn_shift(p.qn, p.kn))));
    bf16_t* DQ = (bf16_t*)(p.ws + WS_DQ); const bf16_t* DK = (const bf16_t*)(p.ws + WS_DK); const bf16_t* DV = (const bf16_t*)(p.ws + WS_DV);
    const unsigned myx = xb_xcc_id() & 7u;
    for (unsigned qi = 0; qi < 8u; ++qi) {
        const unsigned x = (myx + qi) & 7u;
        for (;;) {
            if (wv == 0 && lane_id() == 0) *slot = atomicAdd(ctr + 16 * x, 1u);
            __syncthreads();
            const unsigned i = __builtin_amdgcn_readfirstlane(*slot);
            __syncthreads();
            if (i >= 256u) break;
            const unsigned bh = 4u * x + (i >> 6);
            const int ab = (int)(bh >> 3), ah = (int)(bh & 7), aq = (int)(i & 63);
            if (negm > -64.f) fa::attn_unit2<false>(ab, ah, aq, DQ, DQ, DK, DV, p.dnorm, lam, negm, (char*)smem, wv);
            else fa::attn_unit2<true>(ab, ah, aq, DQ, DQ, DK, DV, p.dnorm, lam, negm, (char*)smem, wv);
        }
    }
#endif
    p0_weights<true>(p, smem, wv);
}

namespace pg8 {
#define PG8_LAS __attribute__((address_space(3)))
typedef unsigned short bf16_t;
typedef short bf16x8 __attribute__((ext_vector_type(8)));
typedef float f32x4 __attribute__((ext_vector_type(4)));
typedef unsigned u32x4 __attribute__((ext_vector_type(4)));
constexpr int BM = 256, BK = 64, HALF = 128, HTB = HALF * BK * 2  , STAGE_BYTES = 8 * HTB, NXCD = 8, WGM = 8;

__host__ __device__ __forceinline__ int lds_byte(int r, int c) { const int st = (r >> 4) * 2 + (c >> 5), rr = r & 15, cc = c & 31, ob = rr * 64 + cc * 2; return st * 1024 + (ob ^ (((ob >> 9) & 1) << 5)); }
__host__ __device__ __forceinline__ void stage_rc(int b, int& R, int& C) { const int st = b / 1024, sb = b % 1024, swz = sb ^ (((sb >> 9) & 1) << 5); R = (st >> 1) * 16 + swz / 64; C = (st & 1) * 32 + (swz % 64) / 2; }
__host__ __device__ __forceinline__ int perm32(int rho) { const int n = rho >> 4, i = rho & 15; return 8 * (i >> 2) + 4 * n + (i & 3); }

struct Unit { int pm, pn, w; };
struct Gemm { const bf16_t* A; const bf16_t* Bt; int M, N, K; const bf16_t* A2; const bf16_t* Bt2; };

struct StaticOrder {
    int nM, nN, nwg, G, c;
    __host__ __device__ void init(int M, int N, int G_, int c_) { nM = M / BM; nN = N / BM; nwg = nM * nN; G = G_; c = c_; }
    __host__ __device__ bool next(int i, Unit& u) const {
        const long L = (long)i * G + c; if (L >= nwg) return false;
        int wgid = (int)L; { const int q = nwg / NXCD, r = nwg % NXCD, xcd = wgid % NXCD, off = wgid / NXCD; wgid = (xcd < r ? xcd * (q + 1) : r * (q + 1) + (xcd - r) * q) + off; }
        const int nig = WGM * nN, gid = wgid / nig, fm = gid * WGM, gsz = (nM - fm) < WGM ? (nM - fm) : WGM;
        u.pm = fm + ((wgid % nig) % gsz); u.pn = (wgid % nig) / gsz; u.w = 0; return true;
    }
    __device__ __forceinline__ void a_ready(const Unit&) const {}
    __device__ __forceinline__ void done(const Unit&) const {}
};
struct DualOrder {
    StaticOrder base;
    __device__ void init(int M, int N, int G_, int c_) { base.init(M, N, G_, c_); }
    __device__ bool next(int i, Unit& u) const { const bool ok = base.next(i >> 1, u); u.w = i & 1; return ok; }
    __device__ __forceinline__ void a_ready(const Unit&) const {}
    __device__ __forceinline__ void done(const Unit&) const {}
};
template <class T, class = void> struct is_chain { static constexpr bool value = false; };
template <class T> struct is_chain<T, decltype((void)T::CHAIN)> { static constexpr bool value = true; };

struct MixOrder : StaticOrder {
    __host__ __device__ bool next(int i, Unit& u) const {
        if (!StaticOrder::next(i, u)) return false;
        const int q = u.pn & 3, r = u.pn >> 2; u.pn = 4 * ((q + r) & 3) + r; return true;
    }
};

typedef float f32x2c_t __attribute__((ext_vector_type(2))); typedef __bf16 bf16x2c_t __attribute__((ext_vector_type(2)));
__device__ __forceinline__ unsigned cvt_pk_bf16(float lo, float hi) { f32x2c_t v = {lo, hi}; bf16x2c_t bb = __builtin_convertvector(v, bf16x2c_t); return __builtin_bit_cast(unsigned, bb); }
template <class Epi, class Sched, bool ALIGN_EPI = false, bool SP2 = false>
__device__ __forceinline__ void gemm_phase(PG8_LAS unsigned char* lds, const Gemm g, const Sched& S, const Epi& E, int wv) {
    const int tid = GET_TID(wv), wid = wv, lane = tid & 63, wr = wid >> 2, wc = wid & 3, fr = lane & 15, fq = lane >> 4;
    const int K = g.K, nt = K / BK;
    unsigned voffA[2], voffB[2];
#pragma unroll
    for (int i = 0; i < 2; ++i) { int R, C; stage_rc(tid * 16 + i * 8192, R, C); const int Rb = Epi::PERM ? ((R & ~31) + perm32(R & 31)) : R;
        voffA[i] = (unsigned)(R * K + C) * 2u; voffB[i] = (unsigned)(Rb * K + C) * 2u; }
    const size_t kstep = (size_t)(BK * 2);
    const size_t hstep = (size_t)HALF * K * 2;
    const size_t tstep = 2 * hstep;
    const unsigned ldsw = (unsigned)wid * 1024u;
    const int aoff = lds_byte(wr * 64 + fr, fq * 8), boff = lds_byte(wc * 32 + fr, fq * 8);
#define PG8_SA(b, h) (((b) * 2 + (h)) * HTB)
#define PG8_SB(b, h) ((4 + (b) * 2 + (h)) * HTB)
#define PG8_STAGE(bufoff, gbase, voff) do { _Pragma("unroll") for (int _i = 0; _i < 2; ++_i) \
        __builtin_amdgcn_global_load_lds((const unsigned*)((const char*)(gbase) + (voff)[_i]), (PG8_LAS unsigned*)(lds + (bufoff) + ldsw + _i * 8192), 16, 0, 0); } while (0)
#define PG8_LDA(dst, b, h) do { _Pragma("unroll") for (int m = 0; m < 4; ++m) _Pragma("unroll") for (int k = 0; k < 2; ++k) dst[m][k] = *(const PG8_LAS bf16x8*)(lds + PG8_SA(b, h) + aoff + m * 2048 + k * 1024); } while (0)
#define PG8_LDB(dst, b, h) do { _Pragma("unroll") for (int n = 0; n < 2; ++n) _Pragma("unroll") for (int k = 0; k < 2; ++k) dst[n][k] = *(const PG8_LAS bf16x8*)(lds + PG8_SB(b, h) + boff + n * 2048 + k * 1024); } while (0)
#define PG8_MMA(ai, bj, At, Bt) do { __builtin_amdgcn_s_setprio(1); _Pragma("unroll") for (int m = 0; m < 4; ++m) _Pragma("unroll") for (int n = 0; n < 2; ++n) _Pragma("unroll") for (int k = 0; k < 2; ++k) \
        acc[ai][bj][m][n] = __builtin_amdgcn_mfma_f32_16x16x32_bf16(Bt[n][k], At[m][k], acc[ai][bj][m][n], 0, 0, 0); __builtin_amdgcn_s_setprio(0); } while (0)
#define PG8_WAIT_V(n) asm volatile("s_waitcnt vmcnt(" #n ")" ::: "memory")
#define PG8_WAIT_L(n) asm volatile("s_waitcnt lgkmcnt(" #n ")" ::: "memory")
#define PG8_BAR __builtin_amdgcn_s_barrier()
#define PG8_SCHED __builtin_amdgcn_sched_barrier(0)
    Unit cur, nxt; int ui = 0;
    if (!S.next(0, cur)) return;
    f32x4 acc[2][2][4][2];
#pragma unroll
    for (int a = 0; a < 2; ++a)
#pragma unroll
        for (int b = 0; b < 2; ++b)
#pragma unroll
            for (int m = 0; m < 4; ++m)
#pragma unroll
                for (int n = 0; n < 2; ++n) acc[a][b][m][n] = (f32x4){0.f, 0.f, 0.f, 0.f};
    bf16x8 At[4][2], B0[2][2], B1[2][2];
    const char* cA = (const char*)(cur.w ? g.A2 : g.A) + (size_t)cur.pm * tstep; const char* cB = (const char*)(cur.w ? g.Bt2 : g.Bt) + (size_t)cur.pn * tstep;
    S.a_ready(cur);
    if constexpr (SP2) {
        PG8_STAGE(PG8_SB(0, 0), cB, voffB); PG8_STAGE(PG8_SB(0, 1), cB + hstep, voffB); PG8_STAGE(PG8_SA(0, 0), cA, voffA); PG8_STAGE(PG8_SA(0, 1), cA + hstep, voffA);
        if (wr == 1) PG8_BAR;
        PG8_WAIT_V(2); PG8_BAR;
        PG8_STAGE(PG8_SB(1, 0), cB + kstep, voffB); PG8_STAGE(PG8_SA(1, 0), cA + kstep, voffA); PG8_STAGE(PG8_SB(1, 1), cB + hstep + kstep, voffB);
        PG8_WAIT_V(6); PG8_BAR;
    } else {
        PG8_STAGE(PG8_SB(0, 0), cB, voffB); PG8_STAGE(PG8_SA(0, 0), cA, voffA); PG8_STAGE(PG8_SB(0, 1), cB + hstep, voffB); PG8_STAGE(PG8_SA(0, 1), cA + hstep, voffA);
        if (wr == 1) PG8_BAR;
        PG8_WAIT_V(4); PG8_BAR;
        PG8_STAGE(PG8_SB(1, 0), cB + kstep, voffB); PG8_STAGE(PG8_SA(1, 0), cA + kstep, voffA); PG8_STAGE(PG8_SB(1, 1), cB + hstep + kstep, voffB);
        PG8_WAIT_V(6); PG8_BAR;
    }
    for (;;) {
        const bool has_next = S.next(ui + 1, nxt);
        const char* nA = has_next ? (const char*)(nxt.w ? g.A2 : g.A) + (size_t)nxt.pm * tstep : cA; const char* nB = has_next ? (const char*)(nxt.w ? g.Bt2 : g.Bt) + (size_t)nxt.pn * tstep : cB;
        for (int t = 0; t < nt; t += 2) {
            const bool last = (t == nt - 2);
            const char* a1 = cA + (size_t)(t + 1) * kstep;
            const char* a2 = last ? nA : cA + (size_t)(t + 2) * kstep; const char* b2 = last ? nB : cB + (size_t)(t + 2) * kstep;
            const char* a3 = a2 + kstep; const char* b3 = b2 + kstep;
            if (last && has_next) S.a_ready(nxt);
            if constexpr (SP2) {
            PG8_LDB(B0, 0, 0); PG8_LDB(B1, 0, 1); PG8_SCHED; PG8_LDA(At, 0, 0); PG8_STAGE(PG8_SA(1, 1), a1 + hstep, voffA);
            PG8_WAIT_V(8); PG8_WAIT_L(0); PG8_BAR; PG8_MMA(0, 0, At, B0); PG8_MMA(0, 1, At, B1); PG8_BAR; PG8_SCHED;
            PG8_LDA(At, 0, 1); PG8_STAGE(PG8_SB(0, 0), b2, voffB); PG8_STAGE(PG8_SB(0, 1), b2 + hstep, voffB); PG8_STAGE(PG8_SA(0, 0), a2, voffA);
            PG8_WAIT_V(8); PG8_WAIT_L(0); PG8_BAR; PG8_MMA(1, 0, At, B0); PG8_MMA(1, 1, At, B1); PG8_BAR; PG8_SCHED;
            PG8_LDB(B0, 1, 0); PG8_LDB(B1, 1, 1); PG8_SCHED; PG8_LDA(At, 1, 0); PG8_STAGE(PG8_SA(0, 1), a2 + hstep, voffA);
            PG8_WAIT_V(8); PG8_WAIT_L(0); PG8_BAR; PG8_MMA(0, 0, At, B0); PG8_MMA(0, 1, At, B1); PG8_BAR; PG8_SCHED;
            PG8_LDA(At, 1, 1); PG8_STAGE(PG8_SB(1, 0), b3, voffB); PG8_STAGE(PG8_SB(1, 1), b3 + hstep, voffB); PG8_STAGE(PG8_SA(1, 0), a3, voffA);
            PG8_WAIT_V(8); PG8_WAIT_L(0); PG8_BAR; PG8_MMA(1, 0, At, B0); PG8_MMA(1, 1, At, B1); PG8_BAR; PG8_SCHED;
            } else {
            PG8_LDB(B0, 0, 0); PG8_SCHED; PG8_LDA(At, 0, 0); PG8_STAGE(PG8_SA(1, 1), a1 + hstep, voffA);
            PG8_WAIT_L(8); PG8_BAR; PG8_WAIT_L(0); PG8_MMA(0, 0, At, B0); PG8_BAR; PG8_SCHED;
            PG8_LDB(B1, 0, 1); PG8_STAGE(PG8_SB(0, 0), b2, voffB);
            PG8_BAR; PG8_WAIT_L(0); PG8_MMA(0, 1, At, B1); PG8_BAR;
            PG8_LDA(At, 0, 1); PG8_STAGE(PG8_SA(0, 0), a2, voffA);
            PG8_BAR; PG8_WAIT_L(0); PG8_MMA(1, 0, At, B0); PG8_BAR; PG8_SCHED;
            PG8_STAGE(PG8_SB(0, 1), b2 + hstep, voffB);
            PG8_WAIT_V(6); PG8_BAR; PG8_MMA(1, 1, At, B1); PG8_BAR;
            PG8_LDB(B0, 1, 0); PG8_SCHED; PG8_LDA(At, 1, 0); PG8_STAGE(PG8_SA(0, 1), a2 + hstep, voffA);
            PG8_WAIT_L(8); PG8_BAR; PG8_WAIT_L(0); PG8_MMA(0, 0, At, B0); PG8_BAR; PG8_SCHED;
            PG8_LDB(B1, 1, 1); PG8_STAGE(PG8_SB(1, 0), b3, voffB);
            PG8_BAR; PG8_WAIT_L(0); PG8_MMA(0, 1, At, B1); PG8_BAR;
            PG8_LDA(At, 1, 1); PG8_STAGE(PG8_SA(1, 0), a3, voffA);
            PG8_BAR; PG8_WAIT_L(0); PG8_MMA(1, 0, At, B0); PG8_BAR; PG8_SCHED;
            PG8_STAGE(PG8_SB(1, 1), b3 + hstep, voffB);
            PG8_WAIT_V(6); PG8_BAR; PG8_MMA(1, 1, At, B1); PG8_BAR;
            }
        }
        if constexpr (ALIGN_EPI) { if (wr == 0) PG8_BAR; }
        if constexpr (!Epi::AFTER_DRAIN) { E(acc, cur, wr, wc, fr, fq); S.done(cur); }
        if (!has_next) break;
        if (!(is_chain<Epi>::value && cur.w == 0)) {
#pragma unroll
        for (int a = 0; a < 2; ++a)
#pragma unroll
            for (int b = 0; b < 2; ++b)
#pragma unroll
                for (int m = 0; m < 4; ++m)
#pragma unroll
                    for (int n = 0; n < 2; ++n) acc[a][b][m][n] = (f32x4){0.f, 0.f, 0.f, 0.f};
        }
        cur = nxt; cA = nA; cB = nB; ++ui;
        if constexpr (ALIGN_EPI) { if (wr == 1) PG8_BAR; }
    }
    PG8_WAIT_V(0);
    if constexpr (!ALIGN_EPI) { if (wr == 0) PG8_BAR; }
    PG8_BAR;
    if constexpr (Epi::AFTER_DRAIN) { E.fused(acc, cur, wr, wc, fr, fq, lds, wid, lane); S.done(cur); }
#undef PG8_SA
#undef PG8_SB
#undef PG8_STAGE
#undef PG8_LDA
#undef PG8_LDB
#undef PG8_MMA
#undef PG8_WAIT_V
#undef PG8_WAIT_L
#undef PG8_BAR
#undef PG8_SCHED
}
}

namespace ep {
using pg8::f32x4; using pg8::Unit; using pg8::cvt_pk_bf16;
typedef unsigned u32x2v __attribute__((ext_vector_type(2)));
#define EP_LAS __attribute__((address_space(3)))
__device__ __forceinline__ u32x2v pack4(f32x4 v) { u32x2v w; w.x = cvt_pk_bf16(v[0], v[1]); w.y = cvt_pk_bf16(v[2], v[3]); return w; }
__device__ __forceinline__ f32x4 unpack4(u32x2v w) { f32x4 v; v[0] = __uint_as_float(w.x << 16); v[1] = __uint_as_float(w.x & 0xffff0000u); v[2] = __uint_as_float(w.y << 16); v[3] = __uint_as_float(w.y & 0xffff0000u); return v; }
__device__ __forceinline__ float fsilu(float v) { return v * __builtin_amdgcn_rcpf(1.f + __builtin_amdgcn_exp2f(-v * LOG2E)); }
__device__ __forceinline__ float fsigm(float v) { return __builtin_amdgcn_rcpf(1.f + __builtin_amdgcn_exp2f(-v * LOG2E)); }
__device__ __forceinline__ f32x4 silu4(f32x4 v) { f32x4 r; r[0] = fsilu(v[0]); r[1] = fsilu(v[1]); r[2] = fsilu(v[2]); r[3] = fsilu(v[3]); return r; }
__device__ __forceinline__ f32x4 sigm4(f32x4 v) { f32x4 r; r[0] = fsigm(v[0]); r[1] = fsigm(v[1]); r[2] = fsigm(v[2]); r[3] = fsigm(v[3]); return r; }
#define EP_BAR() do { asm volatile("s_waitcnt lgkmcnt(0)" ::: "memory"); __builtin_amdgcn_s_barrier(); asm volatile("" ::: "memory"); } while (0)

struct EpiP1 {
    static constexpr bool PERM = true, AFTER_DRAIN = false;
    unsigned char* ws; const float* qn; const float* kn; EP_LAS float* xs;
    __device__ __forceinline__ void operator()(const f32x4 (&acc)[2][2][4][2], const Unit& u, int wr, int wc, int fr, int fq) const {
        const int pn = u.pn, rl = wr * 64 + fr, rbase = u.pm * 256 + rl, cl = wc * 32 + 4 * fq;
        if (pn < 8 || pn >= 16) {
            if (pn == 20) {
                float* LR = (float*)(ws + WS_LR);
                if (wc == 0) {
#pragma unroll
                    for (int ai = 0; ai < 2; ++ai)
#pragma unroll
                        for (int m = 0; m < 4; ++m)
#pragma unroll
                            for (int n = 0; n < 2; ++n) *(f32x4*)(LR + (size_t)(rbase + 128 * ai + 16 * m) * 32 + 8 * fq + 4 * n) = acc[ai][0][m][n];
                }
                return;
            }
            bf16_t* dst; int ld, c0; float sc = 1.f;
            if (pn < 2) { dst = (bf16_t*)(ws + WS_GQ); ld = 512; c0 = 256 * pn; sc = 0.08838834764831845f; }
            else if (pn < 4) { dst = (bf16_t*)(ws + WS_GK); ld = 512; c0 = 256 * (pn - 2); }
            else if (pn < 8) { dst = (bf16_t*)(ws + WS_GV); ld = 1024; c0 = 256 * (pn - 4); }
            else { dst = (bf16_t*)(ws + WS_DV); ld = 1024; c0 = 256 * (pn - 16); }
#pragma unroll
            for (int ai = 0; ai < 2; ++ai)
#pragma unroll
                for (int m = 0; m < 4; ++m) { bf16_t* rp = dst + (size_t)(rbase + 128 * ai + 16 * m) * ld + c0 + wc * 32 + 8 * fq;
#pragma unroll
                    for (int bj = 0; bj < 2; ++bj) { const u32x2v lo = pack4(acc[ai][bj][m][0] * sc), hi2 = pack4(acc[ai][bj][m][1] * sc);
                        *(u32x4*)(rp + 128 * bj) = (u32x4){lo.x, lo.y, hi2.x, hi2.y}; } }
            return;
        }
        const bool isq = pn < 12, lat = u.pm < 128;
        const int c0 = 256 * (pn - (isq ? 8 : 12));
        float ssq[2][4][2];
#pragma unroll
        for (int ai = 0; ai < 2; ++ai)
#pragma unroll
            for (int m = 0; m < 4; ++m)
#pragma unroll
                for (int bj = 0; bj < 2; ++bj) {
                    const f32x4 a = acc[ai][bj][m][0], b = acc[ai][bj][m][1];
                    float s = (a[0] * a[0] + a[1] * a[1]) + (a[2] * a[2] + a[3] * a[3]) + (b[0] * b[0] + b[1] * b[1]) + (b[2] * b[2] + b[3] * b[3]);
                    s += __shfl_xor(s, 16); s += __shfl_xor(s, 32);
                    ssq[ai][m][bj] = s;
                    if (fq == 0) xs[(bj * 4 + wc) * 256 + 128 * ai + 16 * m + rl] = s;
                }
        EP_BAR();
        const float* gain = isq ? qn : kn;
        const int d0 = 32 * (wc & 1) + 4 * fq;
        const f32x4 g0 = *(const f32x4*)(gain + d0), g1 = *(const f32x4*)(gain + d0 + 16);
        const float osc = isq ? QC2 : 1.f;
        const float* TABC = (const float*)(ws + WS_TAB); const float* TABS = TABC + 2048;
        bf16_t* dst = isq ? (bf16_t*)(ws + WS_DQ) : (bf16_t*)(ws + WS_DK);
        if (isq && !lat) return;
#pragma unroll
        for (int ai = 0; ai < 2; ++ai) {
            f32x4 csv[4], snv[4];
#pragma unroll
            for (int m = 0; m < 4; ++m) { csv[m] = (f32x4){1.f, 1.f, 1.f, 1.f}; snv[m] = (f32x4){0.f, 0.f, 0.f, 0.f};
                if (lat) { const int t = (rbase + 128 * ai + 16 * m) & (SEQ - 1), pos = (wc & 1) ? (t & 63) : (t >> 6); csv[m] = *(const f32x4*)(TABC + pos * 16 + 4 * fq); snv[m] = *(const f32x4*)(TABS + pos * 16 + 4 * fq); } }
            asm volatile("" ::: "memory");
#pragma unroll
            for (int m = 0; m < 4; ++m) {
                const int row = rbase + 128 * ai + 16 * m;
                const f32x4 cs = csv[m], sn = snv[m];
#pragma unroll
                for (int bj = 0; bj < 2; ++bj) {
                    const float tot = ssq[ai][m][bj] + xs[(bj * 4 + (wc ^ 1)) * 256 + 128 * ai + 16 * m + rl];
                    const float rstd = rsqrtf(tot * (1.f / 64.f) + EPS) * osc;
                    const f32x4 x0 = acc[ai][bj][m][0] * rstd * g0, x1 = acc[ai][bj][m][1] * rstd * g1;
                    const f32x4 o0 = x0 * cs - x1 * sn, o1 = x1 * cs + x0 * sn;
                    bf16_t* rp = dst + (size_t)row * DM + c0 + 128 * bj + cl;
                    *(u32x2v*)(rp) = pack4(o0); *(u32x2v*)(rp + 16) = pack4(o1);
                }
            }
        }
    }
};
struct EpiP25 {
    static constexpr bool PERM = true, AFTER_DRAIN = false;
    unsigned char* ws; const bf16_t* OF; const float* gla_norm; EP_LAS float* xs;
    __device__ __forceinline__ void operator()(const f32x4 (&acc)[2][2][4][2], const Unit& u, int wr, int wc, int fr, int fq) const {
        int fr_ = fr, fq_ = fq; asm volatile("" : "+v"(fr_), "+v"(fq_));
        const int pn = u.pn, rl = wr * 64 + fr_, rbase = u.pm * 256 + rl, cl = wc * 32 + 8 * fq_;
        if (pn >= 4) {
            bf16_t* dst = pn < 8 ? (bf16_t*)(ws + WS_DQ) : pn < 12 ? (bf16_t*)(ws + WS_SG) : (bf16_t*)(ws + WS_SD);
            const int c0 = 256 * (pn & 3);
            if (pn >= 8) {
#pragma unroll
                for (int ai = 0; ai < 2; ++ai)
#pragma unroll
                    for (int m = 0; m < 4; ++m) { bf16_t* rp = dst + (size_t)(rbase + 128 * ai + 16 * m) * DM + c0 + cl;
#pragma unroll
                        for (int bj = 0; bj < 2; ++bj) { const u32x2v lo = pack4(acc[ai][bj][m][0]), hi2 = pack4(acc[ai][bj][m][1]);
                            *(u32x4*)(rp + 128 * bj) = (u32x4){lo.x, lo.y, hi2.x, hi2.y}; } }
            } else {
#pragma unroll
                for (int aim2 = 0; aim2 < 4; ++aim2) {
                    u32x4 oldv[2][2];
#pragma unroll
                    for (int k = 0; k < 2; ++k)
#pragma unroll
                        for (int bj = 0; bj < 2; ++bj) { const int aim = 2 * aim2 + k; oldv[k][bj] = *(const u32x4*)(dst + (size_t)(rbase + 128 * (aim >> 2) + 16 * (aim & 3)) * DM + c0 + cl + 128 * bj); }
                    asm volatile("" ::: "memory");
#pragma unroll
                    for (int k = 0; k < 2; ++k) { const int aim = 2 * aim2 + k, ai = aim >> 2, m = aim & 3; bf16_t* rp = dst + (size_t)(rbase + 128 * ai + 16 * m) * DM + c0 + cl;
#pragma unroll
                        for (int bj = 0; bj < 2; ++bj) { const u32x4 old = oldv[k][bj];
                            const u32x2v lo = pack4(unpack4((u32x2v){old.x, old.y}) * silu4(acc[ai][bj][m][0])), hi2 = pack4(unpack4((u32x2v){old.z, old.w}) * silu4(acc[ai][bj][m][1]));
                            *(u32x4*)(rp + 128 * bj) = (u32x4){lo.x, lo.y, hi2.x, hi2.y}; } }
                }
            }
            return;
        }
        const bf16_t* OB = OF + (size_t)NLAT * DM;
        const int c0 = 256 * pn;
        float ssq[2][4];
#pragma unroll
        for (int aim2 = 0; aim2 < 4; ++aim2) {
            u32x4 fv[2][2], gv[2][2];
#pragma unroll
            for (int k = 0; k < 2; ++k)
#pragma unroll
                for (int bj = 0; bj < 2; ++bj) { const int aim = 2 * aim2 + k; const size_t ro = (size_t)(rbase + 128 * (aim >> 2) + 16 * (aim & 3)) * DM + c0 + cl + 128 * bj; fv[k][bj] = *(const u32x4*)(OF + ro); gv[k][bj] = *(const u32x4*)(OB + ro); }
#pragma unroll
            for (int k = 0; k < 2; ++k) { const int aim = 2 * aim2 + k, ai = aim >> 2, m = aim & 3; float s = 0.f;
#pragma unroll
                for (int bj = 0; bj < 2; ++bj) { const u32x4 f = fv[k][bj], g = gv[k][bj];
                    const f32x4 o0 = unpack4((u32x2v){f.x, f.y}) + unpack4((u32x2v){g.x, g.y}), o1 = unpack4((u32x2v){f.z, f.w}) + unpack4((u32x2v){g.z, g.w});
                    s += (o0[0] * o0[0] + o0[1] * o0[1]) + (o0[2] * o0[2] + o0[3] * o0[3]) + (o1[0] * o1[0] + o1[1] * o1[1]) + (o1[2] * o1[2] + o1[3] * o1[3]); }
                s += __shfl_xor(s, 16); s += __shfl_xor(s, 32);
                ssq[ai][m] = s;
                if (fq_ == 0) xs[wc * 256 + 128 * ai + 16 * m + rl] = s;
            }
        }
        EP_BAR();
        bf16_t* A = (bf16_t*)(ws + WS_A);
        f32x4 gn[2][2];
#pragma unroll
        for (int bj = 0; bj < 2; ++bj)
#pragma unroll
            for (int n = 0; n < 2; ++n) gn[bj][n] = *(const f32x4*)(gla_norm + 128 * bj + cl + 4 * n);
        u32x4 nfa, nga, nfb, ngb;
        { const size_t ro = (size_t)rbase * DM + c0 + cl; nfa = *(const u32x4*)(OF + ro); nga = *(const u32x4*)(OB + ro); nfb = *(const u32x4*)(OF + ro + 128); ngb = *(const u32x4*)(OB + ro + 128); }
#pragma unroll
        for (int aim = 0; aim < 8; ++aim) { const int ai = aim >> 2, m = aim & 3;
            const u32x4 fa = nfa, ga = nga, fb = nfb, gb = ngb;
            if (aim < 7) { const size_t rn = (size_t)(rbase + 128 * ((aim + 1) >> 2) + 16 * ((aim + 1) & 3)) * DM + c0 + cl; nfa = *(const u32x4*)(OF + rn); nga = *(const u32x4*)(OB + rn); nfb = *(const u32x4*)(OF + rn + 128); ngb = *(const u32x4*)(OB + rn + 128); }
            asm volatile("" ::: "memory");
            const int rr = 128 * ai + 16 * m + rl;
            const float tot = (xs[rr] + xs[256 + rr]) + (xs[512 + rr] + xs[768 + rr]);
            const float rstd = rsqrtf(tot * (1.f / 256.f) + EPS);
            const size_t ro = (size_t)(rbase + 128 * ai + 16 * m) * DM + c0 + cl;
#pragma unroll
            for (int bj = 0; bj < 2; ++bj) { const u32x4 f = bj ? fb : fa, g = bj ? gb : ga;
                const f32x4 o0 = unpack4((u32x2v){f.x, f.y}) + unpack4((u32x2v){g.x, g.y}), o1 = unpack4((u32x2v){f.z, f.w}) + unpack4((u32x2v){g.z, g.w});
                const u32x2v lo = pack4(o0 * rstd * gn[bj][0] * silu4(acc[ai][bj][m][0])), hi2 = pack4(o1 * rstd * gn[bj][1] * silu4(acc[ai][bj][m][1]));
                *(u32x4*)(A + ro + 128 * bj) = (u32x4){lo.x, lo.y, hi2.x, hi2.y}; }
        }
    }
};
template <int PASS> struct EpiY {
    static constexpr bool PERM = true, AFTER_DRAIN = false;
    unsigned char* ws;
    __device__ __forceinline__ void operator()(const f32x4 (&acc)[2][2][4][2], const Unit& u, int wr, int wc, int fr, int fq) const {
        const int rbase = u.pm * 256 + wr * 64 + fr, cl = 256 * u.pn + wc * 32 + 8 * fq;
        bf16_t* Y = (bf16_t*)(ws + WS_Y); const bf16_t* G = (const bf16_t*)(ws + (PASS == 0 ? WS_SG : WS_SD));
#pragma unroll
        for (int aim = 0; aim < (PASS == 1 ? 4 : 2); ++aim) { const int ai = PASS == 1 ? aim >> 1 : aim, m0 = PASS == 1 ? 2 * (aim & 1) : 0, m1 = PASS == 1 ? m0 + 2 : 4;
            u32x4 gtv[4][2], yv[4][2];
#pragma unroll
            for (int m = m0; m < m1; ++m)
#pragma unroll
                for (int bj = 0; bj < 2; ++bj) { const size_t o = (size_t)(rbase + 128 * ai + 16 * m) * DM + cl + 128 * bj; gtv[m][bj] = *(const u32x4*)(G + o); if (PASS == 1) yv[m][bj] = *(const u32x4*)(Y + o); }
            asm volatile("" ::: "memory");
#pragma unroll
            for (int m = m0; m < m1; ++m) { const size_t ro = (size_t)(rbase + 128 * ai + 16 * m) * DM + cl;
#pragma unroll
                for (int bj = 0; bj < 2; ++bj) { const size_t o = ro + 128 * bj;
                    const u32x4 gt = gtv[m][bj];
                    f32x4 v0 = sigm4(unpack4((u32x2v){gt.x, gt.y})) * acc[ai][bj][m][0], v1 = sigm4(unpack4((u32x2v){gt.z, gt.w})) * acc[ai][bj][m][1];
                    if (PASS == 1) { const u32x4 y = yv[m][bj]; v0 = v0 + unpack4((u32x2v){y.x, y.y}); v1 = v1 + unpack4((u32x2v){y.z, y.w}); }
                    const u32x2v lo = pack4(v0), hi2 = pack4(v1);
                    *(u32x4*)(Y + o) = (u32x4){lo.x, lo.y, hi2.x, hi2.y}; } }
        }
    }
};
struct EpiY2 {
    static constexpr bool PERM = true, AFTER_DRAIN = false, CHAIN = true;
    unsigned char* ws;
    static __device__ __forceinline__ f32x4 ope4(f32x4 v) { f32x4 r;
#pragma unroll
        for (int e = 0; e < 4; ++e) r[e] = 1.f + __builtin_amdgcn_exp2f(fminf(v[e] * -LOG2E, 60.f * LOG2E));
        return r; }
    static __device__ __forceinline__ f32x4 rcp4(f32x4 v) { f32x4 r; r[0] = __builtin_amdgcn_rcpf(v[0]); r[1] = __builtin_amdgcn_rcpf(v[1]); r[2] = __builtin_amdgcn_rcpf(v[2]); r[3] = __builtin_amdgcn_rcpf(v[3]); return r; }
    __device__ __forceinline__ void operator()(f32x4 (&acc)[2][2][4][2], const Unit& u, int wr, int wc, int fr, int fq) const {
        const int rbase = u.pm * 256 + wr * 64 + fr, cl = 256 * u.pn + wc * 32 + 8 * fq;
        bf16_t* Y = (bf16_t*)(ws + WS_Y); const bf16_t* GS = (const bf16_t*)(ws + WS_SG); const bf16_t* GD = (const bf16_t*)(ws + WS_SD);
        if (u.w == 0) {
#pragma unroll
            for (int aim = 0; aim < 4; ++aim) { const int ai = aim >> 1, m0 = 2 * (aim & 1);
                u32x4 gsv[2][2], gdv[2][2];
#pragma unroll
                for (int mm = 0; mm < 2; ++mm)
#pragma unroll
                    for (int bj = 0; bj < 2; ++bj) { const size_t o = (size_t)(rbase + 128 * ai + 16 * (m0 + mm)) * DM + cl + 128 * bj; gsv[mm][bj] = *(const u32x4*)(GS + o); gdv[mm][bj] = *(const u32x4*)(GD + o); }
#pragma unroll
                for (int mm = 0; mm < 2; ++mm)
#pragma unroll
                    for (int bj = 0; bj < 2; ++bj) { const u32x4 gs = gsv[mm][bj], gd = gdv[mm][bj];
                        acc[ai][bj][m0 + mm][0] = acc[ai][bj][m0 + mm][0] * (sigm4(unpack4((u32x2v){gs.x, gs.y})) * ope4(unpack4((u32x2v){gd.x, gd.y})));
                        acc[ai][bj][m0 + mm][1] = acc[ai][bj][m0 + mm][1] * (sigm4(unpack4((u32x2v){gs.z, gs.w})) * ope4(unpack4((u32x2v){gd.z, gd.w}))); }
            }
        } else {
            u32x4 gdv[2][4][2];
#pragma unroll
            for (int ai = 0; ai < 2; ++ai)
#pragma unroll
                for (int m = 0; m < 4; ++m)
#pragma unroll
                    for (int bj = 0; bj < 2; ++bj) gdv[ai][m][bj] = *(const u32x4*)(GD + (size_t)(rbase + 128 * ai + 16 * m) * DM + cl + 128 * bj);
            asm volatile("" ::: "memory");
#pragma unroll
            for (int ai = 0; ai < 2; ++ai)
#pragma unroll
                for (int m = 0; m < 4; ++m)
#pragma unroll
                    for (int bj = 0; bj < 2; ++bj) { const size_t o = (size_t)(rbase + 128 * ai + 16 * m) * DM + cl + 128 * bj; const u32x4 gd = gdv[ai][m][bj];
                        const u32x2v lo = pack4(acc[ai][bj][m][0] * rcp4(ope4(unpack4((u32x2v){gd.x, gd.y})))), hi2 = pack4(acc[ai][bj][m][1] * rcp4(ope4(unpack4((u32x2v){gd.z, gd.w}))));
                        *(u32x4*)(Y + o) = (u32x4){lo.x, lo.y, hi2.x, hi2.y}; }
        }
    }
};
struct EpiOut {
    static constexpr bool PERM = true, AFTER_DRAIN = false;
    const float* x; float* out; const float* MOD;
    __device__ __forceinline__ void operator()(const f32x4 (&acc)[2][2][4][2], const Unit& u, int wr, int wc, int fr, int fq) const {
        const int rbase = u.pm * 256 + wr * 64 + fr, cl = 256 * u.pn + wc * 32 + 8 * fq, b = u.pm >> 5;
        f32x4 g[2][2];
#pragma unroll
        for (int bj = 0; bj < 2; ++bj)
#pragma unroll
            for (int n = 0; n < 2; ++n) g[bj][n] = *(const f32x4*)(MOD + b * 3072 + 2048 + cl + 128 * bj + 4 * n);
        const float* __restrict__ xr_ = x; float* __restrict__ or_ = out;
#pragma unroll
        for (int ai = 0; ai < 2; ++ai) {
            f32x4 xv[4][2][2];
#pragma unroll
            for (int m = 0; m < 4; ++m)
#pragma unroll
                for (int bj = 0; bj < 2; ++bj)
#pragma unroll
                    for (int n = 0; n < 2; ++n) xv[m][bj][n] = *(const f32x4*)(xr_ + (size_t)(rbase + 128 * ai + 16 * m) * DM + cl + 128 * bj + 4 * n);
            asm volatile("" ::: "memory");
#pragma unroll
            for (int m = 0; m < 4; ++m)
#pragma unroll
                for (int bj = 0; bj < 2; ++bj)
#pragma unroll
                    for (int n = 0; n < 2; ++n) *(f32x4*)(or_ + (size_t)(rbase + 128 * ai + 16 * m) * DM + cl + 128 * bj + 4 * n) = xv[m][bj][n] + g[bj][n] * acc[ai][bj][m][n];
        }
    }
};
template <class E_> struct Twice { static constexpr bool PERM = E_::PERM, AFTER_DRAIN = false; E_ e;
    __device__ __forceinline__ void operator()(const f32x4 (&acc)[2][2][4][2], const Unit& u, int wr, int wc, int fr, int fq) const { e(acc, u, wr, wc, fr, fq); EP_BAR(); e(acc, u, wr, wc, fr, fq); } };
}

__device__ __forceinline__ void transpose_item(const float* W, int ldw, bf16_t* WT, int item, int nblk, EP_LAS float* scr, int lane, int mode) {
    const int kb = item / nblk, nb = item % nblk, k0 = 64 * kb, n0 = 32 * nb;
    {
        float tw_[32];
        const float* wp_ = W + (size_t)(k0 + (lane >> 5)) * ldw + n0 + (lane & 31);
#pragma unroll
        for (int i = 0; i < 32; ++i) tw_[i] = wp_[(size_t)(2 * i) * ldw];
#pragma unroll
        for (int i = 0; i < 32; ++i) scr[(2 * i + (lane >> 5)) * 33 + (lane & 31)] = tw_[i];
    }
    asm volatile("s_waitcnt lgkmcnt(0)" ::: "memory");
    if (mode == 3) {
        const int kbase = (k0 & ~127) + 2 * ((k0 >> 6) & 1);
#pragma unroll 4
        for (int i = 0; i < 16; ++i) { const int idx = lane + 64 * i, n = idx & 31, j = idx >> 5;
            *(unsigned*)(WT + (size_t)(n0 + n) * DM + kbase + 4 * j) = pk2(scr[j * 33 + n], scr[(32 + j) * 33 + n]); }
    } else {
        const int c = lane & 7;
#pragma unroll
        for (int j = 0; j < 4; ++j) { const int n = (lane >> 3) + 8 * j; const EP_LAS float* sp = scr + (8 * c) * 33 + n;
            u32x4 o; o.x = pk2(sp[0 * 33], sp[1 * 33]); o.y = pk2(sp[2 * 33], sp[3 * 33]); o.z = pk2(sp[4 * 33], sp[5 * 33]); o.w = pk2(sp[6 * 33], sp[7 * 33]);
            int nrow = n0 + n;
            if (mode == 1) nrow = n0 + (8 * ((n >> 2) & 3) + 4 * (n >> 4) + (n & 3));
            if (mode == 2) nrow = (n0 & ~127) + 4 * n + ((n0 >> 5) & 3);
            *(u32x4*)(WT + (size_t)nrow * DM + k0 + 8 * c) = o; }
    }
    asm volatile("s_waitcnt lgkmcnt(0)" ::: "memory");
}
constexpr size_t WS_WINT2 = 12 * MiB, WS_WBRG = 21 * MiB, WS_WBRD = 23 * MiB;
constexpr int N1 = 5376, N2 = 4096;
template <bool LATE>
__device__ __forceinline__ void p0_weights(const Params& p, unsigned char* smem, int wv) {
    int tid = GET_TID(wv); asm volatile("" : "+v"(tid)); const int lane = tid & 63, wave = tid >> 6;
    const int gw = blockIdx.x * 8 + wave, NGW = gridDim.x * 8;
    EP_LAS float* scr = (EP_LAS float*)(smem) + wave * (64 * 33);
    bf16_t* W1 = (bf16_t*)(p.ws + WS_WINT); bf16_t* W2 = (bf16_t*)(p.ws + WS_WINT2);
    unsigned* wctr = (unsigned*)(p.ws + WS_CTR) + 128;
    LAS unsigned* wslot = (LAS unsigned*)(smem + LDS_BYTES - 56);
    for (int fit = LATE ? 0 : gw; LATE || fit < 2576; fit += NGW) {
        if (LATE) {
            __syncthreads();
            if (tid == 0) *wslot = atomicAdd(wctr, 8u);
            __syncthreads();
            const unsigned t = *wslot;
            if (t >= 3584u) break;
            fit = 2576 + (int)t + wave;
        }
        int seg, it;
        if (fit < 512) { seg = fit >> 8; it = fit & 255; }
        else if (fit < 2560) { seg = 2 + ((fit - 512) >> 9); it = (fit - 512) & 511; }
        else if (fit < 2576) { seg = 6; it = fit - 2560; }
        else { seg = 7 + ((fit - 2576) >> 9); it = (fit - 2576) & 511; }
        const float* src; int ldw, width; bf16_t* dst;
        switch (seg) {
            case 0: src = p.w_in + C_GQ; ldw = INW; width = 512; dst = W1; break;
            case 1: src = p.w_in + C_GK; ldw = INW; width = 512; dst = W1 + (size_t)512 * DM; break;
            case 2: src = p.w_in + C_GV; ldw = INW; width = 1024; dst = W1 + (size_t)1024 * DM; break;
            case 3: src = p.w_in + C_DQ; ldw = INW; width = 1024; dst = W1 + (size_t)2048 * DM; break;
            case 4: src = p.w_in + C_DK; ldw = INW; width = 1024; dst = W1 + (size_t)3072 * DM; break;
            case 5: src = p.w_in + C_DV; ldw = INW; width = 1024; dst = W1 + (size_t)4096 * DM; break;
            case 6: src = p.w_in + C_LR; ldw = INW; width = 32; dst = W1 + (size_t)5120 * DM; break;
            case 7: src = p.w_in + C_GG; ldw = INW; width = 1024; dst = W2; break;
            case 8: src = p.w_in + C_DG; ldw = INW; width = 1024; dst = W2 + (size_t)1024 * DM; break;
            case 9: src = p.w_in + C_MG; ldw = INW; width = 1024; dst = W2 + (size_t)2048 * DM; break;
            case 10: src = p.w_in + C_MD; ldw = INW; width = 1024; dst = W2 + (size_t)3072 * DM; break;
            case 11: src = p.w_brg; ldw = DM; width = 1024; dst = (bf16_t*)(p.ws + WS_WBRG); break;
            case 12: src = p.w_brd; ldw = DM; width = 1024; dst = (bf16_t*)(p.ws + WS_WBRD); break;
            default: src = p.w_out; ldw = DM; width = 1024; dst = (bf16_t*)(p.ws + WS_WOUTT); break;
        }
        const int nblk = width / 32;
        transpose_item(src, ldw, dst, it, nblk, scr, lane, (seg == 3 || seg == 4) ? 1 : seg == 8 ? 2 : seg == 12 ? 3 : 0);
    }
}

__global__ void __launch_bounds__(NTHREADS, 2) fwd_kernel(Params p) {
    extern __shared__ __attribute__((aligned(16))) unsigned char smem[];
    cg::grid_group grid = cg::this_grid();
    const int wv = __builtin_amdgcn_readfirstlane((int)threadIdx.x >> 6);
    const int lo = p.ph_lo, hi = p.ph_hi;
    if (threadIdx.x < 16) ((LAS unsigned*)(smem + LDS_BYTES - 128))[threadIdx.x] = 0u;
    __syncthreads();
    unsigned xrank; XcdBarrier bar = xcd_barrier_post((unsigned*)(p.ws + WS_BAR), (volatile LAS unsigned*)(smem + LDS_BYTES - 128), threadIdx.x == 0, xrank);
#define IN(k) (lo <= (k) && (k) < hi)
    if (lo < 0) grid.sync();
#define SEAM(k) do { if (IN(k) && IN((k) + 1)) xcd_barrier(bar, wv == 0 && lane_id() == 0); } while (0)
#ifndef SK0
    if (IN(0)) { p0a_naive(p, wv, smem); p0_weights<false>(p, smem, wv); }
#endif
    SEAM(0);
    {
        LAS unsigned* vw = (LAS unsigned*)(smem + LDS_BYTES - 48);
        if (threadIdx.x == 0) {
            const unsigned G8 = gridDim.x / 8u; bool okx = (gridDim.x % 8u) == 0u;
            for (unsigned j = 0; j < 16u; ++j) { const unsigned cj = xb_ld(&bar.bar[XB_XCNT(j)]); okx = okx && (cj == (j < 8u ? G8 : 0u)); }
            *vw = okx ? (xrank * 8u + (bar.x & 7u)) : (unsigned)blockIdx.x;
        }
        __syncthreads();
    }
#define VCU() ((int)__builtin_amdgcn_readfirstlane(*(LAS unsigned*)(smem + LDS_BYTES - 48)))
#ifndef SK1
    if (IN(1)) { p0b_norm(p, wv);
#if PROBE == 5
        p0b_norm(p, wv);
#endif
    }
#endif
    SEAM(1);
#if PROBE == 10
    if (IN(2)) {
        pg8::Gemm g{(const bf16_t*)(p.ws + WS_Y), (const bf16_t*)(p.ws + WS_WOUTT), NLAT, DM, DM, nullptr, nullptr}; pg8::StaticOrder S; S.init(NLAT, DM, (int)gridDim.x, VCU());
        ep::EpiOut E{p.x, p.out, (const float*)(p.ws + WS_MOD)};
        pg8::gemm_phase<ep::EpiOut, pg8::StaticOrder, true, true>((PG8_LAS unsigned char*)smem, g, S, E, wv);
        xcd_barrier(bar, wv == 0 && lane_id() == 0);
    }
#endif
#ifndef SK2
    if (IN(2)) {
        pg8::Gemm g{(const bf16_t*)(p.ws + WS_H), (const bf16_t*)(p.ws + WS_WINT), NROW, N1, DM, nullptr, nullptr}; pg8::StaticOrder S; S.init(NROW, N1, (int)gridDim.x, VCU());
        ep::EpiP1 E{p.ws, p.qn, p.kn, (EP_LAS float*)(smem + 131072)};
#if PROBE == 7
        ep::Twice<ep::EpiP1> E2{E};
        pg8::gemm_phase<ep::Twice<ep::EpiP1>, pg8::StaticOrder, true, true>((PG8_LAS unsigned char*)smem, g, S, E2, wv);
#else
        pg8::gemm_phase<ep::EpiP1, pg8::StaticOrder, true, true>((PG8_LAS unsigned char*)smem, g, S, E, wv);
#endif
#if PROBE == 2
        pg8::gemm_phase<ep::EpiP1, pg8::StaticOrder, true, true>((PG8_LAS unsigned char*)smem, g, S, E, wv);
#endif
    }
#endif
    SEAM(2);
#ifndef SK3A
    if (IN(3)) { p2a_logdecay(p, smem, wv); xcd_barrier(bar, wv == 0 && lane_id() == 0, blockIdx.x < 32); p2_mixed(p, smem, wv); }
#endif
    SEAM(3);
#ifndef SK5
    if (IN(4)) {
        pg8::Gemm g{(const bf16_t*)(p.ws + WS_H), (const bf16_t*)(p.ws + WS_WINT2), NLAT, N2, DM, nullptr, nullptr}; pg8::MixOrder S; S.init(NLAT, N2, (int)gridDim.x, VCU());
        ep::EpiP25 E{p.ws, (const bf16_t*)p.out, p.gla_norm, (EP_LAS float*)(smem + 131072)};
        pg8::gemm_phase<ep::EpiP25, pg8::MixOrder, true, true>((PG8_LAS unsigned char*)smem, g, S, E, wv);
    }
#endif
    SEAM(4);
#ifndef SK6
    if (IN(5)) {
        pg8::StaticOrder S; S.init(NLAT, DM, (int)gridDim.x, VCU());
#if PROBE == 8
        for (int rep_ = 0; rep_ < 2; ++rep_) {
        { pg8::Gemm g{(const bf16_t*)(p.ws + WS_A), (const bf16_t*)(p.ws + WS_WBRG), NLAT, DM, DM, nullptr, nullptr}; ep::EpiY<0> E{p.ws};
          pg8::gemm_phase<ep::EpiY<0>, pg8::StaticOrder, true, true>((PG8_LAS unsigned char*)smem, g, S, E, wv); }
        { pg8::Gemm g{(const bf16_t*)(p.ws + WS_DQ), (const bf16_t*)(p.ws + WS_WBRD), NLAT, DM, DM, nullptr, nullptr}; ep::EpiY<1> E{p.ws};
          pg8::gemm_phase<ep::EpiY<1>, pg8::StaticOrder, true, true>((PG8_LAS unsigned char*)smem, g, S, E, wv); }
        }
#else
        { pg8::Gemm g{(const bf16_t*)(p.ws + WS_A), (const bf16_t*)(p.ws + WS_WBRG), NLAT, DM, DM, (const bf16_t*)(p.ws + WS_DQ), (const bf16_t*)(p.ws + WS_WBRD)};
          pg8::DualOrder S2; S2.init(NLAT, DM, (int)gridDim.x, VCU()); ep::EpiY2 E{p.ws};
          pg8::gemm_phase<ep::EpiY2, pg8::DualOrder, true, true>((PG8_LAS unsigned char*)smem, g, S2, E, wv); }
#endif
    }
#endif
    SEAM(5);
#ifndef SK7
    if (IN(6)) {
        pg8::Gemm g{(const bf16_t*)(p.ws + WS_Y), (const bf16_t*)(p.ws + WS_WOUTT), NLAT, DM, DM, nullptr, nullptr}; pg8::StaticOrder S; S.init(NLAT, DM, (int)gridDim.x, VCU());
        ep::EpiOut E{p.x, p.out, (const float*)(p.ws + WS_MOD)};
        pg8::gemm_phase<ep::EpiOut, pg8::StaticOrder, true, true>((PG8_LAS unsigned char*)smem, g, S, E, wv);
#if PROBE == 9
        pg8::gemm_phase<ep::EpiOut, pg8::StaticOrder, true, true>((PG8_LAS unsigned char*)smem, g, S, E, wv);
#endif
#if PROBE == 8
        pg8::gemm_phase<ep::EpiOut, pg8::StaticOrder, true, true>((PG8_LAS unsigned char*)smem, g, S, E, wv);
#if PROBE == 9
        pg8::gemm_phase<ep::EpiOut, pg8::StaticOrder, true, true>((PG8_LAS unsigned char*)smem, g, S, E, wv);
#endif
#endif
    }
#endif
}

extern "C" void kernel_launch(void* const* d_in, const int* in_sizes, int n_in, void* d_out, int out_size, void* d_ws, size_t ws_size, hipStream_t stream) {
    static int grid = 0;
    if (grid == 0) {
        if (n_in != 17 || out_size != NLAT * DM || ws_size < WS_END) { fprintf(stderr, "kernel_launch: unexpected shapes n_in %d out %d ws %zu\n", n_in, out_size, ws_size); grid = -1; return; }
        int dev = 0, cus = 0, per_cu = 0;
        hipGetDevice(&dev);
        hipDeviceGetAttribute(&cus, hipDeviceAttributeMultiprocessorCount, dev);
        hipFuncSetAttribute((const void*)fwd_kernel, hipFuncAttributeMaxDynamicSharedMemorySize, LDS_BYTES);
        hipOccupancyMaxActiveBlocksPerMultiprocessor(&per_cu, (const void*)fwd_kernel, NTHREADS, LDS_BYTES);
        if (per_cu < 1) { fprintf(stderr, "kernel_launch: occupancy query says %d blocks per CU\n", per_cu); per_cu = 1; }
        grid = cus * per_cu;
        (void)hipGetLastError();
    }
    if (grid < 0) return;
    hipMemsetAsync((char*)d_ws + WS_MOD, 0, WS_ZERO_BYTES, stream);
    Params p{};
    p.x = (const float*)d_in[0]; p.c = (const float*)d_in[1]; p.ctx = (const float*)d_in[2]; p.c_ctx = (const float*)d_in[3];
    p.w_ada = (const float*)d_in[4]; p.b_ada = (const float*)d_in[5]; p.w_in = (const float*)d_in[6]; p.w_dec = (const float*)d_in[7];
    p.b_dec = (const float*)d_in[8]; p.gla_norm = (const float*)d_in[9]; p.qn = (const float*)d_in[10]; p.kn = (const float*)d_in[11];
    p.dlam = (const float*)d_in[12]; p.dnorm = (const float*)d_in[13]; p.w_brg = (const float*)d_in[14]; p.w_brd = (const float*)d_in[15];
    p.w_out = (const float*)d_in[16];
    p.out = (float*)d_out; p.ws = (unsigned char*)d_ws; p.ph_lo = 0; p.ph_hi = 7;
    void* args[] = {&p};
    hipError_t e = hipLaunchCooperativeKernel((const void*)fwd_kernel, dim3(grid), dim3(NTHREADS), args, LDS_BYTES, stream);
    if (e != hipSuccess) fprintf(stderr, "cooperative launch failed: %s (grid %d)\n", hipGetErrorString(e), grid);
}
```
